# Optimizing an MI355X kernel written in HIP

```python
import jax, jax.numpy as jnp
from jax import lax
import numpy as np

D_MODEL = 1024
BATCH = 8
SEQ = 4096
DEPTH = 1

N_MEM = 256
RMS_EPS = 1e-6
GN_EPS = 1e-5
ATT_HEADS = 8
ATT_HEAD_DIM = 64
ATT_WIDTH = ATT_HEADS * ATT_HEAD_DIM
ROT_DIM = ATT_HEAD_DIM // 4
ROPE_THETA = 500000.0
DILATED_PATTERNS = ((128, 1), (512, 4), (2048, 16))
RET_HEADS = 4
RET_HEAD_DIM = 128
RET_WIDTH = RET_HEADS * RET_HEAD_DIM
RET_CHUNK = 128
RET_ROPE_THETA = 10000.0
MIX_WIDTH = ATT_WIDTH + RET_WIDTH
IN_PROJ_WIDTH = 3 * ATT_WIDTH + 4 * RET_WIDTH
XATT_HEADS = 4
XATT_HEAD_DIM = D_MODEL // XATT_HEADS
FFN_HIDDEN = -(-(8 * D_MODEL) // (3 * 256)) * 256

kernel_name = "hymba_dilated_retention_hybrid_layer"


def rms_norm(x, g):
    xf = x.astype(jnp.float32)
    y = xf * lax.rsqrt(jnp.mean(xf * xf, axis=-1, keepdims=True) + RMS_EPS)
    return (y * g.astype(jnp.float32)).astype(x.dtype)


def rope(x, pos, rot_dim, theta):
    inv = theta ** (-(jnp.arange(0, rot_dim, 2, dtype=jnp.float32) / rot_dim))
    ang = pos.astype(jnp.float32)[:, None] * inv[None, :]
    cos, sin = jnp.cos(ang), jnp.sin(ang)
    xr = x[..., :rot_dim].astype(jnp.float32)
    x1, x2 = xr[..., : rot_dim // 2], xr[..., rot_dim // 2:]
    rot = jnp.concatenate([x1 * cos - x2 * sin, x2 * cos + x1 * sin], axis=-1)
    return jnp.concatenate([rot.astype(x.dtype), x[..., rot_dim:]], axis=-1)


def window_attn_by_stride(q, k, v, window, dilation):
    B, H, S, dh = q.shape
    n_keys = window // dilation
    L = S // dilation
    nb = -(-L // n_keys)
    Lp = nb * n_keys

    def to_classes(t):
        t = t.reshape(B, H, L, dilation, dh).transpose(0, 1, 3, 2, 4)
        return jnp.pad(t, [(0, 0)] * 3 + [(0, Lp - L), (0, 0)])

    def with_prev(t):
        cur = t.reshape(B, H, dilation, nb, n_keys, dh)
        prev = jnp.pad(cur, [(0, 0)] * 3 + [(1, 0), (0, 0), (0, 0)])[:, :, :, :nb]
        return jnp.concatenate([prev, cur], axis=-2)

    qb = to_classes(q).reshape(B, H, dilation, nb, n_keys, dh)
    kb = with_prev(to_classes(k))
    vb = with_prev(to_classes(v)).astype(jnp.float32)
    s = jnp.einsum('bhrnid,bhrnjd->bhrnij', qb, kb).astype(jnp.float32) * (dh ** -0.5)
    i = jnp.arange(n_keys)[:, None]
    j = jnp.arange(2 * n_keys)[None, :]
    band = (j >= i) & (j <= i + n_keys)
    not_before_start = (jnp.arange(nb)[:, None, None] > 0) | (j[None] >= n_keys)
    mask = band[None] & not_before_start
    s = jnp.where(mask, s, -jnp.inf)
    m = jnp.max(s, axis=-1)
    p = jnp.exp(s - m[..., None])
    l = jnp.sum(p, axis=-1)
    o = jnp.einsum('bhrnij,bhrnjd->bhrnid', p, vb) / l[..., None]

    def back(t, has_d):
        if has_d:
            t = t.reshape(B, H, dilation, Lp, dh)[:, :, :, :L]
            return t.transpose(0, 1, 3, 2, 4).reshape(B, H, S, dh)
        t = t.reshape(B, H, dilation, Lp)[:, :, :, :L]
        return t.transpose(0, 1, 3, 2).reshape(B, H, S)

    return back(o, True), back(m, False), back(l, False)


def dilated_attention(q, k, v):
    outs = [window_attn_by_stride(q, k, v, w, r) for (w, r) in DILATED_PATTERNS]
    m_all = jnp.max(jnp.stack([m for _, m, _ in outs], axis=0), axis=0)
    wts = [l * jnp.exp(m - m_all) for _, m, l in outs]
    num = sum(wt[..., None] * o for wt, (o, _, _) in zip(wts, outs))
    den = sum(wts)
    return num / den[..., None]


def retention(q, k, v):
    B, H, S, dk = q.shape
    dv = v.shape[-1]
    C = RET_CHUNK
    nc = S // C
    log_g = jnp.log(1.0 - 2.0 ** (-5.0 - jnp.arange(H, dtype=jnp.float32)))
    n = jnp.arange(C, dtype=jnp.float32)
    rel = n[:, None] - n[None, :]
    decay_mask = jnp.where(rel >= 0, jnp.exp(log_g[:, None, None] * jnp.maximum(rel, 0.0)), 0.0)
    xi = jnp.exp(log_g[:, None] * (n + 1.0))
    zeta = jnp.exp(log_g[:, None] * (C - 1.0 - n))
    chunk_decay = jnp.exp(log_g * C)

    def chunks(t):
        return t.reshape(B, H, nc, C, t.shape[-1]).transpose(2, 0, 1, 3, 4)

    def step(R, qkv):
        qc, kc, vc = qkv
        inner = jnp.einsum('bhnd,bhmd->bhnm', qc, kc) * decay_mask
        o = jnp.einsum('bhnm,bhme->bhne', inner, vc)
        o = o + jnp.einsum('bhnd,bhde->bhne', qc, R) * xi[:, :, None]
        R = R * chunk_decay[:, None, None] + jnp.einsum('bhmd,bhme->bhde', kc * zeta[:, :, None], vc)
        return R, o

    R0 = jnp.zeros((B, H, dk, dv), jnp.float32)
    _, o = lax.scan(step, R0, (chunks(q), chunks(k), chunks(v)))
    return o.transpose(1, 2, 0, 3, 4).reshape(B, H, S, dv)


def hybrid_mixer(h, w_in, attn_gn_g, ret_gn_g, w_out):
    B, S, _ = h.shape
    proj = h @ w_in
    splits = list(np.cumsum([ATT_WIDTH] * 3 + [RET_WIDTH] * 3))
    aq, ak, av, rq, rk, rv, rg = jnp.split(proj, splits, axis=-1)
    pos = jnp.arange(S)

    def heads(t, nh, d):
        return t.reshape(B, S, nh, d).transpose(0, 2, 1, 3)

    aq = rope(heads(aq, ATT_HEADS, ATT_HEAD_DIM), pos, ROT_DIM, ROPE_THETA)
    ak = rope(heads(ak, ATT_HEADS, ATT_HEAD_DIM), pos, ROT_DIM, ROPE_THETA)
    a = dilated_attention(aq, ak, heads(av, ATT_HEADS, ATT_HEAD_DIM))
    a = a * lax.rsqrt(jnp.mean(a * a, axis=-1, keepdims=True) + RMS_EPS)
    a = a.transpose(0, 2, 1, 3).reshape(B, S, ATT_WIDTH) * attn_gn_g.astype(jnp.float32)

    rq = rope(heads(rq, RET_HEADS, RET_HEAD_DIM).astype(jnp.float32), pos, RET_HEAD_DIM, RET_ROPE_THETA)
    rk = rope(heads(rk, RET_HEADS, RET_HEAD_DIM).astype(jnp.float32), pos, RET_HEAD_DIM, RET_ROPE_THETA)
    rk = rk * (RET_HEAD_DIM ** -0.5)
    r = retention(rq, rk, heads(rv, RET_HEADS, RET_HEAD_DIM).astype(jnp.float32))
    mu = jnp.mean(r, axis=-1, keepdims=True)
    var = jnp.mean(jnp.square(r - mu), axis=-1, keepdims=True)
    r = (r - mu) * lax.rsqrt(var + GN_EPS)
    r = r.transpose(0, 2, 1, 3).reshape(B, S, RET_WIDTH) * ret_gn_g.astype(jnp.float32)
    r = jax.nn.silu(rg.astype(jnp.float32)) * r

    y = jnp.concatenate([a, r], axis=-1).astype(h.dtype)
    return y @ w_out


def memory_cross_attn(h, mem, mem_norm_g, w_q, w_kv, w_o):
    B, S, _ = h.shape
    mh = rms_norm(mem, mem_norm_g)
    q = (h @ w_q).reshape(B, S, XATT_HEADS, XATT_HEAD_DIM)
    k, v = jnp.split(mh @ w_kv, 2, axis=-1)
    k = k.reshape(B, N_MEM, XATT_HEADS, XATT_HEAD_DIM)
    v = v.reshape(B, N_MEM, XATT_HEADS, XATT_HEAD_DIM)
    s = jnp.einsum('bshd,bmhd->bhsm', q, k).astype(jnp.float32) * (XATT_HEAD_DIM ** -0.5)
    p = jax.nn.softmax(s, axis=-1)
    o = jnp.einsum('bhsm,bmhd->bshd', p.astype(v.dtype), v).reshape(B, S, D_MODEL)
    return o @ w_o


def swiglu(h, w_gate_up, w_down):
    g, u = jnp.split(h @ w_gate_up, 2, axis=-1)
    return (jax.nn.silu(g) * u) @ w_down


def setup_inputs(seed: int = 0) -> dict:
    key = jax.random.key(seed)
    ks = jax.random.split(key, 20)

    def w(k, shape, fan_in):
        return jax.random.normal(k, shape, jnp.float32) * (fan_in ** -0.5)

    def gain(k, n):
        return 1.0 + 0.05 * jax.random.normal(k, (DEPTH, n), jnp.float32)

    return {
        "x": jax.random.normal(ks[0], (BATCH, SEQ, D_MODEL), jnp.float32),
        "mem": jax.random.normal(ks[1], (BATCH, N_MEM, D_MODEL), jnp.float32),
        "pre_mix_g": gain(ks[2], D_MODEL),
        "post_mix_g": gain(ks[3], D_MODEL),
        "w_in": w(ks[4], (DEPTH, D_MODEL, IN_PROJ_WIDTH), D_MODEL),
        "attn_gn_g": gain(ks[5], ATT_WIDTH),
        "ret_gn_g": gain(ks[6], RET_WIDTH),
        "w_out": w(ks[7], (DEPTH, MIX_WIDTH, D_MODEL), MIX_WIDTH),
        "pre_mem_g": gain(ks[8], D_MODEL),
        "post_mem_g": gain(ks[9], D_MODEL),
        "mem_norm_g": gain(ks[10], D_MODEL),
        "w_q_mem": w(ks[11], (DEPTH, D_MODEL, D_MODEL), D_MODEL),
        "w_kv_mem": w(ks[12], (DEPTH, D_MODEL, 2 * D_MODEL), D_MODEL),
        "w_o_mem": w(ks[13], (DEPTH, D_MODEL, D_MODEL), D_MODEL),
        "pre_ffn_g": gain(ks[14], D_MODEL),
        "post_ffn_g": gain(ks[15], D_MODEL),
        "w_gate_up": w(ks[16], (DEPTH, D_MODEL, 2 * FFN_HIDDEN), D_MODEL),
        "w_down": w(ks[17], (DEPTH, FFN_HIDDEN, D_MODEL), FFN_HIDDEN),
    }


def reference(x, mem, pre_mix_g, post_mix_g, w_in, attn_gn_g, ret_gn_g, w_out,
              pre_mem_g, post_mem_g, mem_norm_g, w_q_mem, w_kv_mem, w_o_mem,
              pre_ffn_g, post_ffn_g, w_gate_up, w_down):
    for l in range(DEPTH):
        y = hybrid_mixer(rms_norm(x, pre_mix_g[l]), w_in[l], attn_gn_g[l], ret_gn_g[l], w_out[l])
        x = x + rms_norm(y, post_mix_g[l])
        y = memory_cross_attn(rms_norm(x, pre_mem_g[l]), mem, mem_norm_g[l],
                              w_q_mem[l], w_kv_mem[l], w_o_mem[l])
        x = x + rms_norm(y, post_mem_g[l])
        y = swiglu(rms_norm(x, pre_ffn_g[l]), w_gate_up[l], w_down[l])
        x = x + rms_norm(y, post_ffn_g[l])
    return x
```

```cpp
#include <hip/hip_runtime.h>
#include <hip/hip_cooperative_groups.h>
#include <cstdio>
#include <cstdint>
#include <cmath>
namespace cg = cooperative_groups;
namespace pg8 {
#define PG8_LAS __attribute__((address_space(3)))
typedef unsigned short bf16_t;
typedef short bf16x8 __attribute__((ext_vector_type(8)));
typedef float f32x4 __attribute__((ext_vector_type(4)));
typedef unsigned u32x4 __attribute__((ext_vector_type(4)));
constexpr int BM = 256, BK = 64, HALF = 128, HTB = HALF * BK * 2  , STAGE_BYTES = 8 * HTB, NXCD = 8, WGM = 8;

__host__ __device__ __forceinline__ int lds_byte(int r, int c) { const int st = (r >> 4) * 2 + (c >> 5), rr = r & 15, cc = c & 31, ob = rr * 64 + cc * 2; return st * 1024 + (ob ^ (((ob >> 9) & 1) << 5)); }
__host__ __device__ __forceinline__ void stage_rc(int b, int& R, int& C) { const int st = b / 1024, sb = b % 1024, swz = sb ^ (((sb >> 9) & 1) << 5); R = (st >> 1) * 16 + swz / 64; C = (st & 1) * 32 + (swz % 64) / 2; }
__host__ __device__ __forceinline__ int perm32(int rho) { const int n = rho >> 4, i = rho & 15; return 8 * (i >> 2) + 4 * n + (i & 3); }

struct Unit { int pm, pn; };
struct Gemm { const bf16_t* A; const bf16_t* Bt; int M, N, K; };

struct StaticOrder {
    int nM, nN, nwg, G, c;
    __host__ __device__ void init(int M, int N, int G_, int c_) { nM = M / BM; nN = N / BM; nwg = nM * nN; G = G_; c = c_; }
    __host__ __device__ bool next(int i, Unit& u) const {
        const long L = (long)i * G + c; if (L >= nwg) return false;
        int wgid = (int)L; { const int q = nwg / NXCD, r = nwg % NXCD, xcd = wgid % NXCD, off = wgid / NXCD; wgid = (xcd < r ? xcd * (q + 1) : r * (q + 1) + (xcd - r) * q) + off; }
        const int nig = WGM * nN, gid = wgid / nig, fm = gid * WGM, gsz = (nM - fm) < WGM ? (nM - fm) : WGM;
        u.pm = fm + ((wgid % nig) % gsz); u.pn = (wgid % nig) / gsz; return true;
    }
    __device__ __forceinline__ void a_ready(const Unit&) const {}
    __device__ __forceinline__ void done(const Unit&) const {}
};
__device__ __forceinline__ unsigned cvt_pk_bf16(float lo, float hi) { unsigned r; asm volatile("v_cvt_pk_bf16_f32 %0, %1, %2" : "=v"(r) : "v"(lo), "v"(hi)); return r; }
template <class Epi, class Sched, bool ALIGN_EPI = false, bool SP2 = false>
__device__ __forceinline__ void gemm_phase(PG8_LAS unsigned char* lds, const Gemm g, const Sched& S, const Epi& E) {
    const int tid = threadIdx.x, wid = __builtin_amdgcn_readfirstlane(tid >> 6), lane = tid & 63, wr = wid >> 2, wc = wid & 3, fr = lane & 15, fq = lane >> 4;
    const int K = g.K, nt = K / BK;
    unsigned voffA[2], voffB[2];
#pragma unroll
    for (int i = 0; i < 2; ++i) { int R, C; stage_rc(tid * 16 + i * 8192, R, C); const int Rb = Epi::PERM ? ((R & ~31) + perm32(R & 31)) : R;
        voffA[i] = (unsigned)(R * K + C) * 2u; voffB[i] = (unsigned)(Rb * K + C) * 2u; }
    const size_t kstep = (size_t)(BK * 2);
    const size_t hstep = (size_t)HALF * K * 2;
    const size_t tstep = 2 * hstep;
    const unsigned ldsw = (unsigned)wid * 1024u;
    const int aoff = lds_byte(wr * 64 + fr, fq * 8), boff = lds_byte(wc * 32 + fr, fq * 8);
#define PG8_SA(b, h) (((b) * 2 + (h)) * HTB)
#define PG8_SB(b, h) ((4 + (b) * 2 + (h)) * HTB)
#define PG8_STAGE(bufoff, gbase, voff) do { _Pragma("unroll") for (int _i = 0; _i < 2; ++_i) \
        __builtin_amdgcn_global_load_lds((const unsigned*)((const char*)(gbase) + (voff)[_i]), (PG8_LAS unsigned*)(lds + (bufoff) + ldsw + _i * 8192), 16, 0, 0); } while (0)
#define PG8_LDA(dst, b, h) do { _Pragma("unroll") for (int m = 0; m < 4; ++m) _Pragma("unroll") for (int k = 0; k < 2; ++k) dst[m][k] = *(const PG8_LAS bf16x8*)(lds + PG8_SA(b, h) + aoff + m * 2048 + k * 1024); } while (0)
#define PG8_LDB(dst, b, h) do { _Pragma("unroll") for (int n = 0; n < 2; ++n) _Pragma("unroll") for (int k = 0; k < 2; ++k) dst[n][k] = *(const PG8_LAS bf16x8*)(lds + PG8_SB(b, h) + boff + n * 2048 + k * 1024); } while (0)
#define PG8_MMA(ai, bj, At, Bt) do { __builtin_amdgcn_s_setprio(1); _Pragma("unroll") for (int m = 0; m < 4; ++m) _Pragma("unroll") for (int n = 0; n < 2; ++n) _Pragma("unroll") for (int k = 0; k < 2; ++k) \
        acc[ai][bj][m][n] = __builtin_amdgcn_mfma_f32_16x16x32_bf16(Bt[n][k], At[m][k], acc[ai][bj][m][n], 0, 0, 0); __builtin_amdgcn_s_setprio(0); } while (0)
#define PG8_WAIT_V(n) asm volatile("s_waitcnt vmcnt(" #n ")" ::: "memory")
#define PG8_WAIT_L(n) asm volatile("s_waitcnt lgkmcnt(" #n ")" ::: "memory")
#define PG8_BAR __builtin_amdgcn_s_barrier()
#define PG8_SCHED __builtin_amdgcn_sched_barrier(0)
    Unit cur, nxt; int ui = 0;
    if (!S.next(0, cur)) return;
    f32x4 acc[2][2][4][2];
#pragma unroll
    for (int a = 0; a < 2; ++a)
#pragma unroll
        for (int b = 0; b < 2; ++b)
#pragma unroll
            for (int m = 0; m < 4; ++m)
#pragma unroll
                for (int n = 0; n < 2; ++n) acc[a][b][m][n] = (f32x4){0.f, 0.f, 0.f, 0.f};
    bf16x8 At[4][2], B0[2][2], B1[2][2];
    const char* cA = (const char*)g.A + (size_t)cur.pm * tstep; const char* cB = (const char*)g.Bt + (size_t)cur.pn * tstep;
    S.a_ready(cur);
    if constexpr (SP2) {
        PG8_STAGE(PG8_SB(0, 0), cB, voffB); PG8_STAGE(PG8_SB(0, 1), cB + hstep, voffB); PG8_STAGE(PG8_SA(0, 0), cA, voffA); PG8_STAGE(PG8_SA(0, 1), cA + hstep, voffA);
        if (wr == 1) PG8_BAR;
        PG8_WAIT_V(2); PG8_BAR;
        PG8_STAGE(PG8_SB(1, 0), cB + kstep, voffB); PG8_STAGE(PG8_SA(1, 0), cA + kstep, voffA); PG8_STAGE(PG8_SB(1, 1), cB + hstep + kstep, voffB);
        PG8_WAIT_V(6); PG8_BAR;
    } else {
        PG8_STAGE(PG8_SB(0, 0), cB, voffB); PG8_STAGE(PG8_SA(0, 0), cA, voffA); PG8_STAGE(PG8_SB(0, 1), cB + hstep, voffB); PG8_STAGE(PG8_SA(0, 1), cA + hstep, voffA);
        if (wr == 1) PG8_BAR;
        PG8_WAIT_V(4); PG8_BAR;
        PG8_STAGE(PG8_SB(1, 0), cB + kstep, voffB); PG8_STAGE(PG8_SA(1, 0), cA + kstep, voffA); PG8_STAGE(PG8_SB(1, 1), cB + hstep + kstep, voffB);
        PG8_WAIT_V(6); PG8_BAR;
    }
    for (;;) {
        const bool has_next = S.next(ui + 1, nxt);
        const char* nA = has_next ? (const char*)g.A + (size_t)nxt.pm * tstep : cA; const char* nB = has_next ? (const char*)g.Bt + (size_t)nxt.pn * tstep : cB;
        for (int t = 0; t < nt; t += 2) {
            const bool last = (t == nt - 2);
            const char* a1 = cA + (size_t)(t + 1) * kstep;
            const char* a2 = last ? nA : cA + (size_t)(t + 2) * kstep; const char* b2 = last ? nB : cB + (size_t)(t + 2) * kstep;
            const char* a3 = a2 + kstep; const char* b3 = b2 + kstep;
            if (last && has_next) S.a_ready(nxt);
            if constexpr (SP2) {
            PG8_LDB(B0, 0, 0); PG8_LDB(B1, 0, 1); PG8_SCHED; PG8_LDA(At, 0, 0); PG8_STAGE(PG8_SA(1, 1), a1 + hstep, voffA);
            PG8_WAIT_V(8); PG8_WAIT_L(0); PG8_BAR; PG8_MMA(0, 0, At, B0); PG8_MMA(0, 1, At, B1); PG8_BAR; PG8_SCHED;
            PG8_LDA(At, 0, 1); PG8_STAGE(PG8_SB(0, 0), b2, voffB); PG8_STAGE(PG8_SB(0, 1), b2 + hstep, voffB); PG8_STAGE(PG8_SA(0, 0), a2, voffA);
            PG8_WAIT_V(8); PG8_WAIT_L(0); PG8_BAR; PG8_MMA(1, 0, At, B0); PG8_MMA(1, 1, At, B1); PG8_BAR; PG8_SCHED;
            PG8_LDB(B0, 1, 0); PG8_LDB(B1, 1, 1); PG8_SCHED; PG8_LDA(At, 1, 0); PG8_STAGE(PG8_SA(0, 1), a2 + hstep, voffA);
            PG8_WAIT_V(8); PG8_WAIT_L(0); PG8_BAR; PG8_MMA(0, 0, At, B0); PG8_MMA(0, 1, At, B1); PG8_BAR; PG8_SCHED;
            PG8_LDA(At, 1, 1); PG8_STAGE(PG8_SB(1, 0), b3, voffB); PG8_STAGE(PG8_SB(1, 1), b3 + hstep, voffB); PG8_STAGE(PG8_SA(1, 0), a3, voffA);
            PG8_WAIT_V(8); PG8_WAIT_L(0); PG8_BAR; PG8_MMA(1, 0, At, B0); PG8_MMA(1, 1, At, B1); PG8_BAR; PG8_SCHED;
            } else {
            PG8_LDB(B0, 0, 0); PG8_SCHED; PG8_LDA(At, 0, 0); PG8_STAGE(PG8_SA(1, 1), a1 + hstep, voffA);
            PG8_WAIT_L(8); PG8_BAR; PG8_WAIT_L(0); PG8_MMA(0, 0, At, B0); PG8_BAR; PG8_SCHED;
            PG8_LDB(B1, 0, 1); PG8_STAGE(PG8_SB(0, 0), b2, voffB);
            PG8_BAR; PG8_WAIT_L(0); PG8_MMA(0, 1, At, B1); PG8_BAR;
            PG8_LDA(At, 0, 1); PG8_STAGE(PG8_SA(0, 0), a2, voffA);
            PG8_BAR; PG8_WAIT_L(0); PG8_MMA(1, 0, At, B0); PG8_BAR; PG8_SCHED;
            PG8_STAGE(PG8_SB(0, 1), b2 + hstep, voffB);
            PG8_WAIT_V(6); PG8_BAR; PG8_MMA(1, 1, At, B1); PG8_BAR;
            PG8_LDB(B0, 1, 0); PG8_SCHED; PG8_LDA(At, 1, 0); PG8_STAGE(PG8_SA(0, 1), a2 + hstep, voffA);
            PG8_WAIT_L(8); PG8_BAR; PG8_WAIT_L(0); PG8_MMA(0, 0, At, B0); PG8_BAR; PG8_SCHED;
            PG8_LDB(B1, 1, 1); PG8_STAGE(PG8_SB(1, 0), b3, voffB);
            PG8_BAR; PG8_WAIT_L(0); PG8_MMA(0, 1, At, B1); PG8_BAR;
            PG8_LDA(At, 1, 1); PG8_STAGE(PG8_SA(1, 0), a3, voffA);
            PG8_BAR; PG8_WAIT_L(0); PG8_MMA(1, 0, At, B0); PG8_BAR; PG8_SCHED;
            PG8_STAGE(PG8_SB(1, 1), b3 + hstep, voffB);
            PG8_WAIT_V(6); PG8_BAR; PG8_MMA(1, 1, At, B1); PG8_BAR;
            }
        }
        if constexpr (ALIGN_EPI) { if (wr == 0) PG8_BAR; }
        if constexpr (!Epi::AFTER_DRAIN) { E(acc, cur, wr, wc, fr, fq); S.done(cur); }
        if (!has_next) break;
#pragma unroll
        for (int a = 0; a < 2; ++a)
#pragma unroll
            for (int b = 0; b < 2; ++b)
#pragma unroll
                for (int m = 0; m < 4; ++m)
#pragma unroll
                    for (int n = 0; n < 2; ++n) acc[a][b][m][n] = (f32x4){0.f, 0.f, 0.f, 0.f};
        cur = nxt; cA = nA; cB = nB; ++ui;
        if constexpr (ALIGN_EPI) { if (wr == 1) PG8_BAR; }
    }
    PG8_WAIT_V(0);
    if constexpr (!ALIGN_EPI) { if (wr == 0) PG8_BAR; }
    PG8_BAR;
    if constexpr (Epi::AFTER_DRAIN) { E.fused(acc, cur, wr, wc, fr, fq, lds, wid, lane); S.done(cur); }
#undef PG8_SA
#undef PG8_SB
#undef PG8_STAGE
#undef PG8_LDA
#undef PG8_LDB
#undef PG8_MMA
#undef PG8_WAIT_V
#undef PG8_WAIT_L
#undef PG8_BAR
#undef PG8_SCHED
}
}
constexpr int NB = 8, SEQ = 4096, DM = 1024, T = NB * SEQ;
constexpr int NMEM = 256, MROWS = NB * NMEM;
constexpr int NPROJ = 3584, FFH = 2816;
constexpr float RMS_EPS = 1e-6f, GN_EPS = 1e-5f;
constexpr float LOG2E = 1.4426950408889634f;

typedef unsigned u32x4 __attribute__((ext_vector_type(4)));
typedef unsigned u32x2 __attribute__((ext_vector_type(2)));
typedef short s16x4 __attribute__((ext_vector_type(4)));
typedef float f32x2 __attribute__((ext_vector_type(2)));
using pg8::bf16_t; using pg8::bf16x8; using pg8::f32x4; using pg8::cvt_pk_bf16;
#define LAS __attribute__((address_space(3)))

__device__ __forceinline__ float bf_lo(unsigned w) { return __uint_as_float(w << 16); }
__device__ __forceinline__ float bf_hi(unsigned w) { return __uint_as_float(w & 0xffff0000u); }
__device__ __forceinline__ float wave_sum(float v) {
#pragma unroll
    for (int o = 1; o < 64; o <<= 1) v += __shfl_xor(v, o);
    return v;
}
__device__ __forceinline__ float fast_exp2(float x) { return __builtin_amdgcn_exp2f(x); }
__device__ __forceinline__ float max3_raw(float a, float b, float c) { float r; asm("v_max3_f32 %0, %1, %2, %3" : "=v"(r) : "v"(a), "v"(b), "v"(c)); return r; }
__device__ __forceinline__ float silu_f(float g) { return g * __builtin_amdgcn_rcpf(1.0f + __expf(-g)); }

namespace pg8 {
struct EpiProj {
    static constexpr bool PERM = true, AFTER_DRAIN = false;
    bf16_t* base; const float* rstd; const f32x2* ropeA; const f32x2* ropeR;
    __device__ __forceinline__ void operator()(const f32x4 (&acc)[2][2][4][2], const Unit& u, int wr, int wc, int fr, int fq) const {
        const int seg = u.pn >> 1;
        bf16_t* O = base + (size_t)seg * ((size_t)T * 512);
        const int c0 = (u.pn & 1) * 256 + wc * 32 + 8 * fq;
        const bool ropeAtt = (seg <= 1) && ((wc & 1) == 0) && (fq < 2);
        const bool ropeRet = (seg == 3) || (seg == 4);
        const float segscale = (seg == 0) ? (0.125f * LOG2E) : ((seg == 4) ? 0.08838834764831845f : 1.0f);
#pragma unroll
        for (int ai = 0; ai < 2; ++ai)
#pragma unroll
            for (int m = 0; m < 4; ++m) {
                const int row = u.pm * BM + ai * HALF + wr * 64 + m * 16 + fr;
                const int pos = row & (SEQ - 1);
                const float rs = rstd[row] * segscale;
#pragma unroll
                for (int bj = 0; bj < 2; ++bj) {
                    const int col = c0 + bj * HALF;
                    f32x4 v0 = acc[ai][bj][m][0] * rs, v1 = acc[ai][bj][m][1] * rs;
                    if (ropeAtt || ropeRet) {
                        const f32x2* tb = ropeRet ? (ropeR + (size_t)pos * 64 + ((col & 127) >> 1)) : (ropeA + (size_t)pos * 8 + ((col & 15) >> 1));
                        const f32x2 t0 = tb[0], t1 = tb[1], t2 = tb[2], t3 = tb[3];
                        f32x4 w0, w1;
                        w0[0] = v0[0] * t0.x - v0[1] * t0.y; w0[1] = v0[1] * t0.x + v0[0] * t0.y;
                        w0[2] = v0[2] * t1.x - v0[3] * t1.y; w0[3] = v0[3] * t1.x + v0[2] * t1.y;
                        w1[0] = v1[0] * t2.x - v1[1] * t2.y; w1[1] = v1[1] * t2.x + v1[0] * t2.y;
                        w1[2] = v1[2] * t3.x - v1[3] * t3.y; w1[3] = v1[3] * t3.x + v1[2] * t3.y;
                        v0 = w0; v1 = w1;
                    }
                    u32x4 w; w.x = cvt_pk_bf16(v0[0], v0[1]); w.y = cvt_pk_bf16(v0[2], v0[3]); w.z = cvt_pk_bf16(v1[0], v1[1]); w.w = cvt_pk_bf16(v1[2], v1[3]);
                    *(u32x4*)(O + (size_t)row * 512 + col) = w;
                }
            }
    }
};
struct EpiScale {
    static constexpr bool PERM = true, AFTER_DRAIN = false;
    bf16_t* O; int ldc; const float* rstd; float scale;
    __device__ __forceinline__ void operator()(const f32x4 (&acc)[2][2][4][2], const Unit& u, int wr, int wc, int fr, int fq) const {
        const int c0 = u.pn * BM + wc * 32 + 8 * fq;
#pragma unroll
        for (int ai = 0; ai < 2; ++ai)
#pragma unroll
            for (int m = 0; m < 4; ++m) {
                const int row = u.pm * BM + ai * HALF + wr * 64 + m * 16 + fr;
                const float rs = rstd[row] * scale;
#pragma unroll
                for (int bj = 0; bj < 2; ++bj) {
                    const f32x4 v0 = acc[ai][bj][m][0] * rs, v1 = acc[ai][bj][m][1] * rs;
                    u32x4 w; w.x = cvt_pk_bf16(v0[0], v0[1]); w.y = cvt_pk_bf16(v0[2], v0[3]); w.z = cvt_pk_bf16(v1[0], v1[1]); w.w = cvt_pk_bf16(v1[2], v1[3]);
                    *(u32x4*)(O + (size_t)row * ldc + c0 + bj * HALF) = w;
                }
            }
    }
};
struct EpiYss {
    static constexpr bool PERM = true, AFTER_DRAIN = false;
    bf16_t* O; float* ss;
    __device__ __forceinline__ void operator()(const f32x4 (&acc)[2][2][4][2], const Unit& u, int wr, int wc, int fr, int fq) const {
        const int c0 = u.pn * BM + wc * 32 + 8 * fq;
#pragma unroll
        for (int ai = 0; ai < 2; ++ai)
#pragma unroll
            for (int m = 0; m < 4; ++m) {
                const int row = u.pm * BM + ai * HALF + wr * 64 + m * 16 + fr;
                float s = 0.f;
#pragma unroll
                for (int bj = 0; bj < 2; ++bj) {
                    const f32x4 v0 = acc[ai][bj][m][0], v1 = acc[ai][bj][m][1];
                    s += (v0[0] * v0[0] + v0[1] * v0[1]) + (v0[2] * v0[2] + v0[3] * v0[3]) + (v1[0] * v1[0] + v1[1] * v1[1]) + (v1[2] * v1[2] + v1[3] * v1[3]);
                    u32x4 w; w.x = cvt_pk_bf16(v0[0], v0[1]); w.y = cvt_pk_bf16(v0[2], v0[3]); w.z = cvt_pk_bf16(v1[0], v1[1]); w.w = cvt_pk_bf16(v1[2], v1[3]);
                    *(u32x4*)(O + (size_t)row * DM + c0 + bj * HALF) = w;
                }
                s += __shfl_xor(s, 16); s += __shfl_xor(s, 32);
                if (fq == 0) ss[((size_t)u.pn * T + row) * 4 + wc] = s;
            }
    }
};
struct EpiSwiGLU {
    static constexpr bool PERM = true, AFTER_DRAIN = false;
    bf16_t* O; const float* rstd;
    __device__ __forceinline__ void operator()(const f32x4 (&acc)[2][2][4][2], const Unit& u, int wr, int wc, int fr, int fq) const {
        const int c0 = u.pn * HALF + wc * 32 + 8 * fq;
#pragma unroll
        for (int ai = 0; ai < 2; ++ai)
#pragma unroll
            for (int m = 0; m < 4; ++m) {
                const int row = u.pm * BM + ai * HALF + wr * 64 + m * 16 + fr;
                const float rs = rstd[row];
                float h[8];
#pragma unroll
                for (int n = 0; n < 2; ++n)
#pragma unroll
                    for (int j = 0; j < 4; ++j) { const float g = acc[ai][0][m][n][j] * rs, up = acc[ai][1][m][n][j] * rs; h[n * 4 + j] = silu_f(g) * up; }
                u32x4 w; w.x = cvt_pk_bf16(h[0], h[1]); w.y = cvt_pk_bf16(h[2], h[3]); w.z = cvt_pk_bf16(h[4], h[5]); w.w = cvt_pk_bf16(h[6], h[7]);
                *(u32x4*)(O + (size_t)row * FFH + c0) = w;
            }
    }
};
}

constexpr size_t MiB = 1u << 20;
constexpr size_t WS_WT_IN = 1 * MiB, WS_WT_OUT = 8 * MiB, WS_WT_Q = 10 * MiB, WS_WT_KV = 12 * MiB, WS_WT_O = 16 * MiB, WS_WT_GU = 18 * MiB, WS_WT_DN = 29 * MiB;
constexpr size_t WS_ROPEA = 35 * MiB, WS_ROPER = 36 * MiB, WS_RSTD = 38 * MiB, WS_SS = 39 * MiB, WS_MEMB = 40 * MiB, WS_MEMKV = 44 * MiB, WS_AST = 52 * MiB;
constexpr size_t WS_XB = 56 * MiB, WS_KVT = 56 * MiB;
constexpr size_t WS_YOUT = 120 * MiB, WS_AO = 120 * MiB;
constexpr size_t WS_YMIX = 184 * MiB, WS_PROJ = 248 * MiB, WS_RB = 472 * MiB, WS_SSP = 504 * MiB, WS_END = 510 * MiB;
constexpr size_t SEGE = (size_t)T * 512;

struct Params {
    const float* in[18];
    float* out; unsigned char* ws;
    float inv_att[8]; float inv_ret[64];
    int pad[2];
};

constexpr int LDS_BYTES = 139264;

__device__ __forceinline__ unsigned f2bf(float f) { unsigned u = __builtin_bit_cast(unsigned, f); return (u + 0x7fffu + ((u >> 16) & 1u)) >> 16; }
__device__ __forceinline__ unsigned pk2(float lo, float hi) { return f2bf(lo) | (f2bf(hi) << 16); }

__device__ __forceinline__ int map_win(int n) {
    const int seg = n >> 9, w = n & 511;
    if (seg <= 1) { const int d = w & 63; const int nd = d < 8 ? 2 * d : (d < 16 ? 2 * (d - 8) + 1 : d); return (n & ~63) + nd; }
    if (seg == 3 || seg == 4) { const int d = w & 127; const int nd = d < 64 ? 2 * d : 2 * (d - 64) + 1; return (n & ~127) + nd; }
    return n;
}
__device__ __forceinline__ int map_gu(int n) { const int isu = n >= FFH ? 1 : 0; const int j = n - isu * FFH; return 256 * (j >> 7) + 128 * isu + (j & 127); }

template <int MAP>
__device__ __forceinline__ void transpose_item(const float* W, const float* gain, int K, int N, bf16_t* WT, LAS float* scr, int item, int lane) {
    const int nblk = N / 32, kb = item / nblk, nb = item % nblk, k0 = 64 * kb, n0 = 32 * nb;
#pragma unroll 16
    for (int i = 0; i < 32; ++i) { const int kk = 2 * i + (lane >> 5); const float g = gain ? gain[k0 + kk] : 1.0f; scr[kk * 33 + (lane & 31)] = __builtin_nontemporal_load(W + (size_t)(k0 + kk) * N + n0 + (lane & 31)) * g; }
    asm volatile("s_waitcnt lgkmcnt(0)" ::: "memory");
    const int c = lane & 7;
#pragma unroll
    for (int j = 0; j < 4; ++j) { const int n = (lane >> 3) + 8 * j; const LAS float* s = scr + (8 * c) * 33 + n;
        u32x4 o; o.x = pk2(s[0 * 33], s[1 * 33]); o.y = pk2(s[2 * 33], s[3 * 33]); o.z = pk2(s[4 * 33], s[5 * 33]); o.w = pk2(s[6 * 33], s[7 * 33]);
        const int nn = n0 + n; const int dr = MAP == 1 ? map_win(nn) : (MAP == 2 ? map_gu(nn) : nn);
        *(u32x4*)(WT + (size_t)dr * K + k0 + 8 * c) = o; }
    asm volatile("s_waitcnt lgkmcnt(0)" ::: "memory");
}

__device__ __forceinline__ void row_to_bf16(const float* xrow, bf16_t* orow, float* rstd_out, int lane) {
    const f32x4* xr = (const f32x4*)xrow + lane;
    f32x4 v[4]; float s = 0.f;
#pragma unroll
    for (int j = 0; j < 4; ++j) { v[j] = xr[64 * j]; s += (v[j][0] * v[j][0] + v[j][1] * v[j][1]) + (v[j][2] * v[j][2] + v[j][3] * v[j][3]); }
    s = wave_sum(s);
    u32x2* o8 = (u32x2*)orow + lane;
#pragma unroll
    for (int j = 0; j < 4; ++j) { u32x2 w; w.x = cvt_pk_bf16(v[j][0], v[j][1]); w.y = cvt_pk_bf16(v[j][2], v[j][3]); o8[64 * j] = w; }
    if (lane == 0) *rstd_out = 1.0f / sqrtf(s * (1.0f / DM) + RMS_EPS);
}

template <bool FINAL>
__device__ __forceinline__ void residual_pass(bf16_t* xb, const bf16_t* y, const float* ss, const float* g, float* xout, float* rstd_out) {
    const int bid = blockIdx.x, nblk = gridDim.x, lane = threadIdx.x & 63, wave = __builtin_amdgcn_readfirstlane(threadIdx.x >> 6);
    f32x4 gv[4];
#pragma unroll
    for (int j = 0; j < 4; ++j) gv[j] = ((const f32x4*)g)[lane + 64 * j];
    for (int ch = bid >> 3; ch < SEQ / 32; ch += nblk >> 3)
    for (int row = (bid & 7) * SEQ + ch * 32 + wave; row < (bid & 7) * SEQ + ch * 32 + 32; row += 8) {
        u32x2* xr = (u32x2*)(xb + (size_t)row * DM) + lane;
        const u32x2* yr = (const u32x2*)(y + (size_t)row * DM) + lane;
        float sq = ss[((size_t)((lane >> 2) & 3) * T + row) * 4 + (lane & 3)];
        sq += __shfl_xor(sq, 1); sq += __shfl_xor(sq, 2); sq += __shfl_xor(sq, 4); sq += __shfl_xor(sq, 8);
        const float r = 1.0f / sqrtf(sq * (1.0f / DM) + RMS_EPS);
        f32x4 v[4]; float s = 0.f;
#pragma unroll
        for (int j = 0; j < 4; ++j) {
            const u32x2 xw = xr[64 * j], yw = yr[64 * j];
            f32x4 xv, yv; xv[0] = bf_lo(xw.x); xv[1] = bf_hi(xw.x); xv[2] = bf_lo(xw.y); xv[3] = bf_hi(xw.y);
            yv[0] = bf_lo(yw.x); yv[1] = bf_hi(yw.x); yv[2] = bf_lo(yw.y); yv[3] = bf_hi(yw.y);
            v[j] = xv + yv * r * gv[j];
            s += (v[j][0] * v[j][0] + v[j][1] * v[j][1]) + (v[j][2] * v[j][2] + v[j][3] * v[j][3]);
        }
        if (FINAL) {
            f32x4* orow = (f32x4*)(xout + (size_t)row * DM) + lane;
#pragma unroll
            for (int j = 0; j < 4; ++j) __builtin_nontemporal_store(v[j], orow + 64 * j);
        } else {
            s = wave_sum(s);
#pragma unroll
            for (int j = 0; j < 4; ++j) { u32x2 w; w.x = cvt_pk_bf16(v[j][0], v[j][1]); w.y = cvt_pk_bf16(v[j][2], v[j][3]); xr[64 * j] = w; }
            if (lane == 0) rstd_out[row] = 1.0f / sqrtf(s * (1.0f / DM) + RMS_EPS);
        }
    }
}

__device__ __forceinline__ void rows2_to_bf16(const float* x0, const float* x1, bf16_t* o0, bf16_t* o1, float* r0, float* r1, int lane) {
    const f32x4* xa = (const f32x4*)x0 + lane; const f32x4* xb_ = (const f32x4*)x1 + lane;
    f32x4 va[4], vb[4]; float sa = 0.f, sb = 0.f;
#pragma unroll
    for (int j = 0; j < 4; ++j) { va[j] = __builtin_nontemporal_load(xa + 64 * j); vb[j] = __builtin_nontemporal_load(xb_ + 64 * j); }
#pragma unroll
    for (int j = 0; j < 4; ++j) { sa += (va[j][0] * va[j][0] + va[j][1] * va[j][1]) + (va[j][2] * va[j][2] + va[j][3] * va[j][3]); sb += (vb[j][0] * vb[j][0] + vb[j][1] * vb[j][1]) + (vb[j][2] * vb[j][2] + vb[j][3] * vb[j][3]); }
    sa = wave_sum(sa); sb = wave_sum(sb);
    u32x2* pa = (u32x2*)o0 + lane; u32x2* pb = (u32x2*)o1 + lane;
#pragma unroll
    for (int j = 0; j < 4; ++j) { u32x2 w; w.x = cvt_pk_bf16(va[j][0], va[j][1]); w.y = cvt_pk_bf16(va[j][2], va[j][3]); pa[64 * j] = w; w.x = cvt_pk_bf16(vb[j][0], vb[j][1]); w.y = cvt_pk_bf16(vb[j][2], vb[j][3]); pb[64 * j] = w; }
    if (lane == 0) { *r0 = 1.0f / sqrtf(sa * (1.0f / DM) + RMS_EPS); *r1 = 1.0f / sqrtf(sb * (1.0f / DM) + RMS_EPS); }
}

__device__ __forceinline__ f32x4 mfma16(bf16x8 a, bf16x8 b, f32x4 c) { return __builtin_amdgcn_mfma_f32_16x16x32_bf16(a, b, c, 0, 0, 0); }
__device__ __forceinline__ s16x4 tr_read(const LAS unsigned char* p) { return __builtin_bit_cast(s16x4, __builtin_amdgcn_ds_read_tr16_b64_v4i16((LAS s16x4*)p)); }
__device__ __forceinline__ bf16x8 tr_pair(const LAS unsigned char* p, int hi_off) {
    const s16x4 lo = tr_read(p), hi = tr_read(p + hi_off);
    return (bf16x8){lo[0], lo[1], lo[2], lo[3], hi[0], hi[1], hi[2], hi[3]};
}
typedef __bf16 bf16x2_t __attribute__((ext_vector_type(2)));
__device__ __forceinline__ unsigned cvtpk_c(float lo, float hi) { const f32x2 v = {lo, hi}; const bf16x2_t b = __builtin_convertvector(v, bf16x2_t); return __builtin_bit_cast(unsigned, b); }
__device__ __forceinline__ bf16x8 pack8(const f32x4 a, const f32x4 b) {
    u32x4 w; w.x = cvtpk_c(a[0], a[1]); w.y = cvtpk_c(a[2], a[3]); w.z = cvtpk_c(b[0], b[1]); w.w = cvtpk_c(b[2], b[3]);
    return __builtin_bit_cast(bf16x8, w);
}
__device__ __forceinline__ u32x4 scale8(u32x4 v, float s) {
    u32x4 o;
    o.x = cvtpk_c(bf_lo(v.x) * s, bf_hi(v.x) * s); o.y = cvtpk_c(bf_lo(v.y) * s, bf_hi(v.y) * s);
    o.z = cvtpk_c(bf_lo(v.z) * s, bf_hi(v.z) * s); o.w = cvtpk_c(bf_lo(v.w) * s, bf_hi(v.w) * s);
    return o;
}

constexpr int AT_STRIDE = 144;
constexpr int AT_KOFF = 0, AT_VOFF = 288 * AT_STRIDE;
__device__ __forceinline__ void attn_load(u32x4 (&kv)[4], u32x4 (&vv)[4], bf16x8 (&qq)[2], int p, int b, int h, int c, int n, const bf16_t* QA, const bf16_t* KA, const bf16_t* VA) {
    const int tid = threadIdx.x, r = 1 << (2 * p);
    { const int lane = tid & 63, w = tid >> 6; const size_t qrow = (size_t)(b * SEQ + c + r * (128 * n + 16 * w + (lane & 15)));
      qq[0] = *(const bf16x8*)(QA + qrow * 512 + h * 64 + 8 * (lane >> 4)); qq[1] = *(const bf16x8*)(QA + qrow * 512 + h * 64 + 32 + 8 * (lane >> 4)); }
#pragma unroll
    for (int it = 0; it < 4; ++it) {
        const int idx = tid + 512 * it, row = idx >> 3, pc = idx & 7;
        const int uk = 128 * (n - 1) + row;
        kv[it] = (u32x4){0u, 0u, 0u, 0u}; vv[it] = (u32x4){0u, 0u, 0u, 0u};
        if (uk >= 0) {
            const size_t g = ((size_t)(b * SEQ + c + r * uk)) * 512 + h * 64 + pc * 8;
            kv[it] = *(const u32x4*)(KA + g); vv[it] = *(const u32x4*)(VA + g);
        }
    }
}
template <bool MERGE>
__device__ __forceinline__ void attn_unit(LAS unsigned char* lds, u32x4 (&kv)[4], u32x4 (&vv)[4], bf16x8 (&qq)[2], int p, int b, int h, int c, int n,
                                          bool has_next, int np, int nh, int nc, int nn,
                                          const bf16_t* QA, const bf16_t* KA, const bf16_t* VA,
                                          bf16_t* AO, f32x2* AST, const float* gn_g, bf16_t* YMIX) {
    const int tid = threadIdx.x, lane = tid & 63, w = __builtin_amdgcn_readfirstlane(tid >> 6), fr = lane & 15, fq = lane >> 4;
    const int r = 1 << (2 * p);
    __syncthreads();
    {
#pragma unroll
        for (int it = 0; it < 4; ++it) {
            const int idx = tid + 512 * it, row = idx >> 3, pc = idx & 7;
            *(LAS u32x4*)(lds + AT_KOFF + row * AT_STRIDE + pc * 16) = kv[it];
            *(LAS u32x4*)(lds + AT_VOFF + row * AT_STRIDE + pc * 16) = vv[it];
        }
        if (tid < 256) { const int row = 256 + (tid >> 3), pc = tid & 7;
            *(LAS u32x4*)(lds + AT_KOFF + row * AT_STRIDE + pc * 16) = (u32x4){0u, 0u, 0u, 0u};
            *(LAS u32x4*)(lds + AT_VOFF + row * AT_STRIDE + pc * 16) = (u32x4){0u, 0u, 0u, 0u}; }
    }
    const int i = 16 * w + fr;
    const size_t qrow = (size_t)(b * SEQ + c + r * (128 * n + i));
    const bf16x8 q0 = qq[0], q1 = qq[1];
    if (has_next) attn_load(kv, vv, qq, np, b, nh, nc, nn, QA, KA, VA);
    f32x2 s0 = {0.f, 0.f}, s1 = {0.f, 0.f}; u32x2 x0[4], x1[4];
    if (MERGE) {
        const size_t sti = (size_t)(b * 8 + h) * SEQ + (qrow - (size_t)b * SEQ);
        s0 = AST[sti]; s1 = AST[(size_t)64 * SEQ + sti];
        const bf16_t* a0 = AO + qrow * 512 + h * 64 + 4 * fq; const bf16_t* a1 = a0 + SEGE;
#pragma unroll
        for (int dt = 0; dt < 4; ++dt) { x0[dt] = *(const u32x2*)(a0 + 16 * dt); x1[dt] = *(const u32x2*)(a1 + 16 * dt); }
    }
    __syncthreads();
    f32x4 sa[5], sb[5];
#pragma unroll
    for (int g = 0; g < 5; ++g) {
        const int rowa = 16 * w + 32 * g + 8 * (fr >> 2) + (fr & 3);
        const LAS unsigned char* ka = lds + AT_KOFF + rowa * AT_STRIDE + fq * 16;
        const bf16x8 ka0 = *(const LAS bf16x8*)(ka), ka1 = *(const LAS bf16x8*)(ka + 64);
        const bf16x8 kb0 = *(const LAS bf16x8*)(ka + 4 * AT_STRIDE), kb1 = *(const LAS bf16x8*)(ka + 4 * AT_STRIDE + 64);
        f32x4 z = {0.f, 0.f, 0.f, 0.f};
        sa[g] = mfma16(ka0, q0, z); sa[g] = mfma16(ka1, q1, sa[g]);
        sb[g] = mfma16(kb0, q0, z); sb[g] = mfma16(kb1, q1, sb[g]);
    }
#pragma unroll
    for (int j = 0; j < 4; ++j) {
        const int da = 8 * fq + j - fr, db = da + 4;
        sa[0][j] += (da < 0) ? -1e30f : 0.f; sb[0][j] += (db < 0) ? -1e30f : 0.f;
        sa[4][j] += (da > 0) ? -1e30f : 0.f; sb[4][j] += (db > 0) ? -1e30f : 0.f;
    }
    if (n == 0) {
#pragma unroll
        for (int g = 0; g < 5; ++g)
#pragma unroll
            for (int j = 0; j < 4; ++j) {
                const int ka_ = 16 * w + 32 * g + 8 * fq + j;
                sa[g][j] = (ka_ >= 128) ? sa[g][j] : -1e30f; sb[g][j] = (ka_ + 4 >= 128) ? sb[g][j] : -1e30f;
            }
    }
    float mx = -1e30f;
#pragma unroll
    for (int g = 0; g < 5; ++g)
#pragma unroll
        for (int j = 0; j < 4; ++j) mx = max3_raw(mx, sa[g][j], sb[g][j]);
    mx = fmaxf(mx, __shfl_xor(mx, 16)); mx = fmaxf(mx, __shfl_xor(mx, 32));
    const f32x4 mx4 = {mx, mx, mx, mx};
    f32x4 l4 = {0.f, 0.f, 0.f, 0.f};
#pragma unroll
    for (int g = 0; g < 5; ++g) {
        sa[g] = sa[g] - mx4; sb[g] = sb[g] - mx4;
#pragma unroll
        for (int j = 0; j < 4; ++j) { sa[g][j] = fast_exp2(sa[g][j]); sb[g][j] = fast_exp2(sb[g][j]); }
        l4 = l4 + sa[g]; l4 = l4 + sb[g];
    }
    float l = (l4[0] + l4[1]) + (l4[2] + l4[3]);
    l += __shfl_xor(l, 16); l += __shfl_xor(l, 32);
    f32x4 o[4];
#pragma unroll
    for (int dt = 0; dt < 4; ++dt) o[dt] = (f32x4){0.f, 0.f, 0.f, 0.f};
#pragma unroll
    for (int g = 0; g < 5; ++g) {
        const bf16x8 P = pack8(sa[g], sb[g]);
        const LAS unsigned char* vb = lds + AT_VOFF + (16 * w + 32 * g + 8 * fq + (fr >> 2)) * AT_STRIDE + 8 * (fr & 3);
#pragma unroll
        for (int dt = 0; dt < 4; ++dt) o[dt] = mfma16(tr_pair(vb + 32 * dt, 4 * AT_STRIDE), P, o[dt]);
    }
    const float il = __builtin_amdgcn_rcpf(l);
#pragma unroll
    for (int dt = 0; dt < 4; ++dt) o[dt] = o[dt] * il;
    if (!MERGE) {
        bf16_t* dst = AO + (size_t)p * SEGE + qrow * 512 + h * 64 + 4 * fq;
#pragma unroll
        for (int dt = 0; dt < 4; ++dt) { u32x2 wv; wv.x = cvt_pk_bf16(o[dt][0], o[dt][1]); wv.y = cvt_pk_bf16(o[dt][2], o[dt][3]); *(u32x2*)(dst + 16 * dt) = wv; }
        if (fq == 0) AST[((size_t)p * 64 + b * 8 + h) * SEQ + (qrow - (size_t)b * SEQ)] = (f32x2){mx, l};
    } else {
        const float mall = fmaxf(mx, fmaxf(s0.x, s1.x));
        const float w0 = s0.y * fast_exp2(s0.x - mall), w1 = s1.y * fast_exp2(s1.x - mall), w2 = l * fast_exp2(mx - mall);
        const float iw = __builtin_amdgcn_rcpf(w0 + w1 + w2);
        float ssq = 0.f;
#pragma unroll
        for (int dt = 0; dt < 4; ++dt) {
            f32x4 v;
            v[0] = (w0 * bf_lo(x0[dt].x) + w1 * bf_lo(x1[dt].x) + w2 * o[dt][0]) * iw;
            v[1] = (w0 * bf_hi(x0[dt].x) + w1 * bf_hi(x1[dt].x) + w2 * o[dt][1]) * iw;
            v[2] = (w0 * bf_lo(x0[dt].y) + w1 * bf_lo(x1[dt].y) + w2 * o[dt][2]) * iw;
            v[3] = (w0 * bf_hi(x0[dt].y) + w1 * bf_hi(x1[dt].y) + w2 * o[dt][3]) * iw;
            o[dt] = v; ssq += (v[0] * v[0] + v[1] * v[1]) + (v[2] * v[2] + v[3] * v[3]);
        }
        ssq += __shfl_xor(ssq, 16); ssq += __shfl_xor(ssq, 32);
        const float rn = __builtin_amdgcn_rsqf(ssq * (1.0f / 64.0f) + RMS_EPS);
        bf16_t* dst = YMIX + qrow * DM + h * 64 + 4 * fq;
#pragma unroll
        for (int dt = 0; dt < 4; ++dt) {
            const f32x4 gg = *(const f32x4*)(gn_g + h * 64 + 16 * dt + 4 * fq);
            u32x2 wv; wv.x = cvt_pk_bf16(o[dt][0] * rn * gg[0], o[dt][1] * rn * gg[1]); wv.y = cvt_pk_bf16(o[dt][2] * rn * gg[2], o[dt][3] * rn * gg[3]);
            *(u32x2*)(dst + 16 * dt) = wv;
        }
    }
}

__device__ __forceinline__ void attn_decode_a(int lu, int& p, int& h, int& c, int& n) {
    const bool p1 = lu >= 256; const int v = p1 ? lu - 256 : lu, w_ = v & 63;
    p = p1 ? 1 : 0; c = p1 ? (v >> 6) : 0; h = p1 ? (w_ >> 3) : (v >> 5); n = p1 ? (w_ & 7) : (v & 31);
}
constexpr int RT_STRIDE = 272;
constexpr int RT_KOFF = 0, RT_VOFF = 128 * RT_STRIDE, RT_ROFF = 2 * 128 * RT_STRIDE;
__device__ __forceinline__ float ret_log2g(int h) { return log2f(1.0f - exp2f(-5.0f - (float)h)); }

__device__ __forceinline__ void ret_stage(LAS unsigned char* lds, const bf16_t* KR, const bf16_t* VR, size_t row0, int h, float vs_a, float vs_b) {
    const int tid = threadIdx.x;
    u32x4 kv[4], vv[4];
#pragma unroll
    for (int it = 0; it < 4; ++it) {
        const int idx = tid + 512 * it, row = idx >> 4, pc = idx & 15;
        const size_t g = (row0 + row) * 512 + h * 128 + pc * 8;
        kv[it] = *(const u32x4*)(KR + g); vv[it] = *(const u32x4*)(VR + g);
    }
#pragma unroll
    for (int it = 0; it < 4; ++it) {
        const int idx = tid + 512 * it, row = idx >> 4, pc = idx & 15;
        *(LAS u32x4*)(lds + RT_KOFF + row * RT_STRIDE + pc * 16) = kv[it];
        *(LAS u32x4*)(lds + RT_VOFF + row * RT_STRIDE + pc * 16) = scale8(vv[it], fast_exp2(vs_a + vs_b * (float)row));
    }
}

__device__ __forceinline__ void ret_state_unit(LAS unsigned char* lds, int b, int h, int c, const bf16_t* KR, const bf16_t* VR, float* KVT) {
    const int tid = threadIdx.x, lane = tid & 63, w = __builtin_amdgcn_readfirstlane(tid >> 6), fr = lane & 15, fq = lane >> 4;
    const float lg = ret_log2g(h);
    __syncthreads();
    ret_stage(lds, KR, VR, (size_t)b * SEQ + 128 * c, h, 127.0f * lg, -lg);
    __syncthreads();
    f32x4 acc[8];
#pragma unroll
    for (int dt = 0; dt < 8; ++dt) acc[dt] = (f32x4){0.f, 0.f, 0.f, 0.f};
#pragma unroll
    for (int ks = 0; ks < 4; ++ks) {
        const int mrow = 32 * ks + 8 * fq + (fr >> 2);
        const bf16x8 A = tr_pair(lds + RT_VOFF + mrow * RT_STRIDE + 32 * w + 8 * (fr & 3), 4 * RT_STRIDE);
        const LAS unsigned char* kb = lds + RT_KOFF + mrow * RT_STRIDE + 8 * (fr & 3);
#pragma unroll
        for (int dt = 0; dt < 8; ++dt) acc[dt] = mfma16(A, tr_pair(kb + 32 * dt, 4 * RT_STRIDE), acc[dt]);
    }
    float* dst = KVT + (((size_t)(b * 4 + h) * 32 + c) * 128 + 16 * w + 4 * fq) * 128 + fr;
#pragma unroll
    for (int dt = 0; dt < 8; ++dt)
#pragma unroll
        for (int j = 0; j < 4; ++j) dst[j * 128 + 16 * dt] = acc[dt][j];
}

__device__ __forceinline__ void ret_out_unit(LAS unsigned char* lds, int b, int h, int c, const bf16_t* QR, const bf16_t* KR, const bf16_t* VR, const bf16_t* GR,
                                             const bf16_t* RB, const float* gn_g, bf16_t* YMIX) {
    const int tid = threadIdx.x, lane = tid & 63, w = __builtin_amdgcn_readfirstlane(tid >> 6), fr = lane & 15, fq = lane >> 4;
    const float lg = ret_log2g(h);
    const size_t row0 = (size_t)b * SEQ + 128 * c;
    __syncthreads();
    ret_stage(lds, KR, VR, row0, h, -lg, -lg);
    {
        const bf16_t* rsrc = RB + ((size_t)(b * 4 + h) * 32 + c) * 16384;
        u32x4 rv[4];
#pragma unroll
        for (int it = 0; it < 4; ++it) { const int idx = tid + 512 * it; rv[it] = *(const u32x4*)(rsrc + (size_t)idx * 8); }
#pragma unroll
        for (int it = 0; it < 4; ++it) { const int idx = tid + 512 * it, row = idx >> 4, pc = idx & 15; *(LAS u32x4*)(lds + RT_ROFF + row * RT_STRIDE + pc * 16) = rv[it]; }
    }
    const int nq = 16 * w + fr;
    bf16x8 q[4];
#pragma unroll
    for (int ks = 0; ks < 4; ++ks) q[ks] = *(const bf16x8*)(QR + (row0 + nq) * 512 + h * 128 + 32 * ks + 8 * fq);
    __syncthreads();
    f32x4 o[8];
#pragma unroll
    for (int et = 0; et < 8; ++et) o[et] = (f32x4){0.f, 0.f, 0.f, 0.f};
    const LAS unsigned char* rb = lds + RT_ROFF + fr * RT_STRIDE + fq * 16;
#pragma unroll
    for (int et = 0; et < 8; ++et)
#pragma unroll
        for (int ks = 0; ks < 4; ++ks) o[et] = mfma16(*(const LAS bf16x8*)(rb + et * 16 * RT_STRIDE + 64 * ks), q[ks], o[et]);
    const int ng = (w >> 1) + 1;
    for (int g = 0; g < ng; ++g) {
        const int rowa = 32 * g + 8 * (fr >> 2) + (fr & 3);
        const LAS unsigned char* ka = lds + RT_KOFF + rowa * RT_STRIDE + fq * 16;
        f32x4 sa = {0.f, 0.f, 0.f, 0.f}, sb = {0.f, 0.f, 0.f, 0.f};
#pragma unroll
        for (int ks = 0; ks < 4; ++ks) {
            sa = mfma16(*(const LAS bf16x8*)(ka + 64 * ks), q[ks], sa);
            sb = mfma16(*(const LAS bf16x8*)(ka + 4 * RT_STRIDE + 64 * ks), q[ks], sb);
        }
#pragma unroll
        for (int j = 0; j < 4; ++j) { const int ma = 32 * g + 8 * fq + j; sa[j] = (ma <= nq) ? sa[j] : 0.f; sb[j] = (ma + 4 <= nq) ? sb[j] : 0.f; }
        const bf16x8 P = pack8(sa, sb);
        const LAS unsigned char* vb = lds + RT_VOFF + (32 * g + 8 * fq + (fr >> 2)) * RT_STRIDE + 8 * (fr & 3);
#pragma unroll
        for (int et = 0; et < 8; ++et) o[et] = mfma16(tr_pair(vb + 32 * et, 4 * RT_STRIDE), P, o[et]);
    }
    const float xi = fast_exp2(lg * (float)(nq + 1));
    float s = 0.f;
#pragma unroll
    for (int et = 0; et < 8; ++et) { o[et] = o[et] * xi; s += (o[et][0] + o[et][1]) + (o[et][2] + o[et][3]); }
    s += __shfl_xor(s, 16); s += __shfl_xor(s, 32);
    const float mu = s * (1.0f / 128.0f);
    float v2 = 0.f;
#pragma unroll
    for (int et = 0; et < 8; ++et) { o[et] = o[et] - mu; v2 += (o[et][0] * o[et][0] + o[et][1] * o[et][1]) + (o[et][2] * o[et][2] + o[et][3] * o[et][3]); }
    v2 += __shfl_xor(v2, 16); v2 += __shfl_xor(v2, 32);
    const float rn = __builtin_amdgcn_rsqf(v2 * (1.0f / 128.0f) + GN_EPS);
    const bf16_t* gp = GR + (row0 + nq) * 512 + h * 128 + 4 * fq;
    bf16_t* dst = YMIX + (row0 + nq) * DM + 512 + h * 128 + 4 * fq;
#pragma unroll
    for (int et = 0; et < 8; ++et) {
        const u32x2 gw = *(const u32x2*)(gp + 16 * et);
        const f32x4 gg = *(const f32x4*)(gn_g + h * 128 + 16 * et + 4 * fq);
        const float r0 = silu_f(bf_lo(gw.x)) * (o[et][0] * rn * gg[0]), r1 = silu_f(bf_hi(gw.x)) * (o[et][1] * rn * gg[1]);
        const float r2 = silu_f(bf_lo(gw.y)) * (o[et][2] * rn * gg[2]), r3 = silu_f(bf_hi(gw.y)) * (o[et][3] * rn * gg[3]);
        u32x2 wv; wv.x = cvt_pk_bf16(r0, r1); wv.y = cvt_pk_bf16(r2, r3);
        *(u32x2*)(dst + 16 * et) = wv;
    }
}

constexpr int XS_BUF = 256 * AT_STRIDE;
__device__ __forceinline__ void xs_load(u32x4 (&v)[4], const bf16_t* src  ) {
    const int tid = threadIdx.x;
#pragma unroll
    for (int it = 0; it < 4; ++it) { const int idx = tid + 512 * it, row = idx >> 3, pc = idx & 7; v[it] = *(const u32x4*)(src + (size_t)row * 2048 + pc * 8); }
}
__device__ __forceinline__ void xs_store(LAS unsigned char* buf, const u32x4 (&v)[4]) {
    const int tid = threadIdx.x;
#pragma unroll
    for (int it = 0; it < 4; ++it) { const int idx = tid + 512 * it, row = idx >> 3, pc = idx & 7; *(LAS u32x4*)(buf + row * AT_STRIDE + pc * 16) = v[it]; }
}
__device__ __forceinline__ void xattn_qload(bf16x8 (&q)[8], int b, int h, int qb, const bf16_t* QX_) {
    const int tid = threadIdx.x, lane = tid & 63, w = tid >> 6;
    const size_t qrow = (size_t)b * SEQ + 128 * qb + 16 * w + (lane & 15);
#pragma unroll
    for (int ks = 0; ks < 8; ++ks) q[ks] = *(const bf16x8*)(QX_ + qrow * DM + h * 256 + 32 * ks + 8 * (lane >> 4));
}
__device__ __forceinline__ void xattn_unit(LAS unsigned char* lds, u32x4 (&pv)[4], u32x4 (&pw)[4], bf16x8 (&qn)[8], int b, int h, int qb, bool has_next, int nh, int nqb,
                                           const bf16_t* QX_, const bf16_t* MKV, bf16_t* OX_) {
    const int tid = threadIdx.x, lane = tid & 63, w = __builtin_amdgcn_readfirstlane(tid >> 6), fr = lane & 15, fq = lane >> 4;
    const size_t qrow = (size_t)b * SEQ + 128 * qb + 16 * w + fr;
    const bf16_t* kbase = MKV + (size_t)(b * NMEM) * 2048 + h * 256;
    const bf16_t* vbase = kbase + 1024;
    bf16x8 q[8];
#pragma unroll
    for (int ks = 0; ks < 8; ++ks) q[ks] = qn[ks];
    f32x4 sa[8], sb[8];
#pragma unroll
    for (int g = 0; g < 8; ++g) { sa[g] = (f32x4){0.f, 0.f, 0.f, 0.f}; sb[g] = (f32x4){0.f, 0.f, 0.f, 0.f}; }
#pragma unroll
    for (int s = 0; s < 4; ++s) {
        LAS unsigned char* buf = lds + (s & 1) * XS_BUF;
        if ((s & 1) == 0) { xs_store(buf, pv); xs_load(pv, s < 2 ? kbase + 64 * (s + 2) : vbase + 64 * (s - 2)); }
        else              { xs_store(buf, pw); xs_load(pw, s < 2 ? kbase + 64 * (s + 2) : vbase + 64 * (s - 2)); }
        __syncthreads();
#pragma unroll
        for (int g = 0; g < 8; ++g) {
            const int rowa = 32 * g + 8 * (fr >> 2) + (fr & 3);
            const LAS unsigned char* ka = buf + rowa * AT_STRIDE + fq * 16;
            sa[g] = mfma16(*(const LAS bf16x8*)(ka), q[2 * s], sa[g]);
            sa[g] = mfma16(*(const LAS bf16x8*)(ka + 64), q[2 * s + 1], sa[g]);
            sb[g] = mfma16(*(const LAS bf16x8*)(ka + 4 * AT_STRIDE), q[2 * s], sb[g]);
            sb[g] = mfma16(*(const LAS bf16x8*)(ka + 4 * AT_STRIDE + 64), q[2 * s + 1], sb[g]);
        }
    }
    float mx = -1e30f;
#pragma unroll
    for (int g = 0; g < 8; ++g)
#pragma unroll
        for (int j = 0; j < 4; ++j) mx = max3_raw(mx, sa[g][j], sb[g][j]);
    mx = fmaxf(mx, __shfl_xor(mx, 16)); mx = fmaxf(mx, __shfl_xor(mx, 32));
    const f32x4 mx4 = {mx, mx, mx, mx};
    f32x4 l4 = {0.f, 0.f, 0.f, 0.f};
    bf16x8 P[8];
#pragma unroll
    for (int g = 0; g < 8; ++g) {
        sa[g] = sa[g] - mx4; sb[g] = sb[g] - mx4;
#pragma unroll
        for (int j = 0; j < 4; ++j) { sa[g][j] = fast_exp2(sa[g][j]); sb[g][j] = fast_exp2(sb[g][j]); }
        l4 = l4 + sa[g]; l4 = l4 + sb[g];
        P[g] = pack8(sa[g], sb[g]);
    }
    float l = (l4[0] + l4[1]) + (l4[2] + l4[3]);
    l += __shfl_xor(l, 16); l += __shfl_xor(l, 32);
    const float il = __builtin_amdgcn_rcpf(l);
    bf16_t* dst = OX_ + qrow * DM + h * 256 + 4 * fq;
#pragma unroll
    for (int s = 0; s < 4; ++s) {
        LAS unsigned char* buf = lds + (s & 1) * XS_BUF;
        const bf16_t* nk = MKV + (size_t)(b * NMEM) * 2048 + nh * 256;
        if ((s & 1) == 0) { xs_store(buf, pv); if (s < 2) xs_load(pv, vbase + 64 * (s + 2)); else if (has_next) xs_load(pv, nk); }
        else              { xs_store(buf, pw); if (s < 2) xs_load(pw, vbase + 64 * (s + 2)); else if (has_next) xs_load(pw, nk + 64); }
        if (s == 0 && has_next) xattn_qload(qn, b, nh, nqb, QX_);
        __syncthreads();
        f32x4 o[4];
#pragma unroll
        for (int dt = 0; dt < 4; ++dt) o[dt] = (f32x4){0.f, 0.f, 0.f, 0.f};
#pragma unroll
        for (int g = 0; g < 8; ++g) {
            const LAS unsigned char* vb = buf + (32 * g + 8 * fq + (fr >> 2)) * AT_STRIDE + 8 * (fr & 3);
#pragma unroll
            for (int dt = 0; dt < 4; ++dt) o[dt] = mfma16(tr_pair(vb + 32 * dt, 4 * AT_STRIDE), P[g], o[dt]);
        }
#pragma unroll
        for (int dt = 0; dt < 4; ++dt) { u32x2 wv; wv.x = cvt_pk_bf16(o[dt][0] * il, o[dt][1] * il); wv.y = cvt_pk_bf16(o[dt][2] * il, o[dt][3] * il); *(u32x2*)(dst + 64 * s + 16 * dt) = wv; }
    }
}

__device__ __forceinline__ void grid_barrier(unsigned* bar, unsigned round) {
    asm volatile("s_waitcnt vmcnt(0) lgkmcnt(0)" ::: "memory");
    __syncthreads();
    if (threadIdx.x == 0) {
        __builtin_amdgcn_fence(__ATOMIC_RELEASE, "agent");
        asm volatile("s_waitcnt vmcnt(0)" ::: "memory");
        const unsigned G = gridDim.x;
        if ((G & 7u) == 0u) {
            const unsigned g = blockIdx.x & 7u, per = G >> 3;
            unsigned* cnt = bar + 64 * (1 + g); unsigned* gen = bar + 64 * (9 + g); unsigned* top = bar + 64 * 17;
            const unsigned old = __hip_atomic_fetch_add(cnt, 1u, __ATOMIC_RELAXED, __HIP_MEMORY_SCOPE_AGENT);
            if (old + 1u == round * per) {
                __hip_atomic_fetch_add(top, 1u, __ATOMIC_RELAXED, __HIP_MEMORY_SCOPE_AGENT);
                while (__hip_atomic_load(top, __ATOMIC_RELAXED, __HIP_MEMORY_SCOPE_AGENT) < round * 8u) __builtin_amdgcn_s_sleep(1);
                __hip_atomic_store(gen, round, __ATOMIC_RELAXED, __HIP_MEMORY_SCOPE_AGENT);
            } else {
                while (__hip_atomic_load(gen, __ATOMIC_RELAXED, __HIP_MEMORY_SCOPE_AGENT) < round) __builtin_amdgcn_s_sleep(1);
            }
        } else {
            __hip_atomic_fetch_add(bar, 1u, __ATOMIC_RELAXED, __HIP_MEMORY_SCOPE_AGENT);
            while (__hip_atomic_load(bar, __ATOMIC_RELAXED, __HIP_MEMORY_SCOPE_AGENT) < round * G) __builtin_amdgcn_s_sleep(2);
        }
        __builtin_amdgcn_fence(__ATOMIC_ACQUIRE, "agent");
        asm volatile("s_waitcnt vmcnt(0)" ::: "memory");
    }
    __syncthreads();
}
__device__ __forceinline__ void grid_barrier_xcd(unsigned* bar, unsigned round, volatile LAS unsigned* ctl) {
    asm volatile("s_waitcnt vmcnt(0) lgkmcnt(0)" ::: "memory");
    __syncthreads();
    if (threadIdx.x == 0) {
        const unsigned x = ctl[0], per = ctl[1], nx = ctl[2], r1 = round - 1u;
        unsigned* cnt = bar + 64 * (26 + x); unsigned* gen = bar + 64 * (34 + x); unsigned* top = bar + 64 * 42;
        const unsigned old = __hip_atomic_fetch_add(cnt, 1u, __ATOMIC_RELAXED, __HIP_MEMORY_SCOPE_AGENT);
        if (old + 1u == r1 * per) {
            __builtin_amdgcn_fence(__ATOMIC_RELEASE, "agent");
            asm volatile("s_waitcnt vmcnt(0)" ::: "memory");
            __hip_atomic_fetch_add(top, 1u, __ATOMIC_RELAXED, __HIP_MEMORY_SCOPE_AGENT);
            while (__hip_atomic_load(top, __ATOMIC_RELAXED, __HIP_MEMORY_SCOPE_AGENT) < r1 * nx) __builtin_amdgcn_s_sleep(1);
            __hip_atomic_store(gen, round, __ATOMIC_RELAXED, __HIP_MEMORY_SCOPE_AGENT);
        } else {
            while (__hip_atomic_load(gen, __ATOMIC_RELAXED, __HIP_MEMORY_SCOPE_AGENT) < round) __builtin_amdgcn_s_sleep(1);
        }
        __builtin_amdgcn_fence(__ATOMIC_ACQUIRE, "agent");
        asm volatile("s_waitcnt vmcnt(0)" ::: "memory");
    }
    __syncthreads();
}
#define GRID_SYNC() do { ++bar_round; \
    if (bar_round == 1) { grid_barrier((unsigned*)P.ws, 1u); \
        if (threadIdx.x == 0) { unsigned nx_ = 0u; for (unsigned j_ = 0; j_ < 8u; ++j_) { const unsigned c_ = __hip_atomic_load((unsigned*)P.ws + 64 * (18 + j_), __ATOMIC_RELAXED, __HIP_MEMORY_SCOPE_AGENT); nx_ += c_ ? 1u : 0u; if (j_ == bctl[0]) bctl[1] = c_; } bctl[2] = nx_; } } \
    else grid_barrier_xcd((unsigned*)P.ws, (unsigned)bar_round, bctl); } while (0)
__global__ void __launch_bounds__(512, 2) hymba_fwd(Params P) {
    extern __shared__ __attribute__((aligned(16))) unsigned char lds_raw[];
    LAS unsigned char* lds = (LAS unsigned char*)lds_raw;
    cg::grid_group grid = cg::this_grid();
    const int tid = threadIdx.x, lane = tid & 63, wave = __builtin_amdgcn_readfirstlane(tid >> 6);
    const int G = gridDim.x, bid = blockIdx.x;
    int bar_round = 0;
    volatile LAS unsigned* bctl = (volatile LAS unsigned*)(lds + 135168);
    if (threadIdx.x == 0) {
        const unsigned xcc = (unsigned)__builtin_amdgcn_s_getreg((3 << 11) | 20) & 7u;
        bctl[0] = xcc;
        __hip_atomic_fetch_add((unsigned*)P.ws + 64 * (18 + xcc), 1u, __ATOMIC_RELAXED, __HIP_MEMORY_SCOPE_AGENT);
    }
    const int gw = bid * 8 + wave, NGW = G * 8;
    const int xcd = bid & 7, slot = bid >> 3, nslot = G >> 3;
#define WSP(TYPE, OFF) ((TYPE*)(P.ws + (OFF)))
#define XIN (P.in[0])
#define MEMIN (P.in[1])
#define WT_IN WSP(bf16_t, WS_WT_IN)
#define WT_OUT WSP(bf16_t, WS_WT_OUT)
#define WT_Q WSP(bf16_t, WS_WT_Q)
#define WT_KV WSP(bf16_t, WS_WT_KV)
#define WT_O WSP(bf16_t, WS_WT_O)
#define WT_GU WSP(bf16_t, WS_WT_GU)
#define WT_DN WSP(bf16_t, WS_WT_DN)
#define ROPEA WSP(f32x2, WS_ROPEA)
#define ROPER WSP(f32x2, WS_ROPER)
#define RSTD0 WSP(float, WS_RSTD)
#define RSTD1 (WSP(float, WS_RSTD) + T)
#define RSTD2 (WSP(float, WS_RSTD) + 2 * T)
#define RSTDM (WSP(float, WS_RSTD) + 3 * T)
#define SS1 WSP(float, WS_SSP)
#define SS2 (WSP(float, WS_SSP) + (size_t)T * 16)
#define SS3 (WSP(float, WS_SSP) + (size_t)T * 32)
#define MEMB WSP(bf16_t, WS_MEMB)
#define MEMKV WSP(bf16_t, WS_MEMKV)
#define AST WSP(f32x2, WS_AST)
#define XB WSP(bf16_t, WS_XB)
#define KVT (P.out)
#define YOUT WSP(bf16_t, WS_YOUT)
#define AO WSP(bf16_t, WS_AO)
#define YMIX WSP(bf16_t, WS_YMIX)
#define PROJ WSP(bf16_t, WS_PROJ)
#define RB WSP(bf16_t, WS_RB)
#define QA PROJ
#define KA (PROJ + SEGE)
#define VA (PROJ + 2 * SEGE)
#define QR (PROJ + 3 * SEGE)
#define KR (PROJ + 4 * SEGE)
#define VR (PROJ + 5 * SEGE)
#define GR (PROJ + 6 * SEGE)
#define QX PROJ
#define OX (PROJ + 2 * SEGE)
#define HFF PROJ

    {
        LAS float* scr = (LAS float*)(lds + wave * 16384);
        constexpr int I_IN = (DM / 64) * (NPROJ / 32), I_SQ = (DM / 64) * (DM / 32), I_KV = (DM / 64) * (2 * DM / 32), I_GU = (DM / 64) * (2 * FFH / 32), I_DN = (FFH / 64) * (DM / 32);
        constexpr int NITEMS = I_IN + 3 * I_SQ + I_KV + I_GU + I_DN;
        if (wave < 4) {
        for (int it = gw; it < NITEMS; it += NGW) {
            int r = it;
            if (r < I_IN) { transpose_item<1>(P.in[4], P.in[2], DM, NPROJ, WT_IN, scr, r, lane); continue; } r -= I_IN;
            if (r < I_SQ) { transpose_item<0>(P.in[7], nullptr, DM, DM, WT_OUT, scr, r, lane); continue; } r -= I_SQ;
            if (r < I_SQ) { transpose_item<0>(P.in[11], P.in[8], DM, DM, WT_Q, scr, r, lane); continue; } r -= I_SQ;
            if (r < I_KV) { transpose_item<0>(P.in[12], P.in[10], DM, 2 * DM, WT_KV, scr, r, lane); continue; } r -= I_KV;
            if (r < I_SQ) { transpose_item<0>(P.in[13], nullptr, DM, DM, WT_O, scr, r, lane); continue; } r -= I_SQ;
            if (r < I_GU) { transpose_item<2>(P.in[16], P.in[14], DM, 2 * FFH, WT_GU, scr, r, lane); continue; } r -= I_GU;
            transpose_item<0>(P.in[17], nullptr, FFH, DM, WT_DN, scr, r, lane);
        }
        }
        for (int pb = bid * 16; pb < SEQ; pb += G * 16)
        for (int idx = tid; idx < 16 * 72; idx += 512) {
            const int pos = pb + idx / 72, k = idx % 72;
            const float inv = k < 8 ? P.inv_att[k] : P.inv_ret[k - 8];
            const float ang = (float)pos * inv;
            const double a = (double)ang;
            const double kk = __builtin_rint(a * 0.15915494309189535);
            const float rr = (float)(a - kk * 6.283185307179586);
            const f32x2 cs = {__cosf(rr), __sinf(rr)};
            if (k < 8) ROPEA[pos * 8 + k] = cs; else ROPER[pos * 64 + (k - 8)] = cs;
        }
        for (int ch = slot; ch < SEQ / 32; ch += nslot)
            for (int row = xcd * SEQ + ch * 32 + wave; row < xcd * SEQ + ch * 32 + 32; row += 16)
                rows2_to_bf16(XIN + (size_t)row * DM, XIN + (size_t)(row + 8) * DM, XB + (size_t)row * DM, XB + (size_t)(row + 8) * DM, RSTD0 + row, RSTD0 + row + 8, lane);
        if (wave >= 4) {
        for (int it = gw; it < NITEMS; it += NGW) {
            int r = it;
            if (r < I_IN) { transpose_item<1>(P.in[4], P.in[2], DM, NPROJ, WT_IN, scr, r, lane); continue; } r -= I_IN;
            if (r < I_SQ) { transpose_item<0>(P.in[7], nullptr, DM, DM, WT_OUT, scr, r, lane); continue; } r -= I_SQ;
            if (r < I_SQ) { transpose_item<0>(P.in[11], P.in[8], DM, DM, WT_Q, scr, r, lane); continue; } r -= I_SQ;
            if (r < I_KV) { transpose_item<0>(P.in[12], P.in[10], DM, 2 * DM, WT_KV, scr, r, lane); continue; } r -= I_KV;
            if (r < I_SQ) { transpose_item<0>(P.in[13], nullptr, DM, DM, WT_O, scr, r, lane); continue; } r -= I_SQ;
            if (r < I_GU) { transpose_item<2>(P.in[16], P.in[14], DM, 2 * FFH, WT_GU, scr, r, lane); continue; } r -= I_GU;
            transpose_item<0>(P.in[17], nullptr, FFH, DM, WT_DN, scr, r, lane);
        }
        }
        for (int ch = slot; ch < NMEM / 32; ch += nslot)
            for (int row = xcd * NMEM + ch * 32 + wave; row < xcd * NMEM + ch * 32 + 32; row += 8) row_to_bf16(MEMIN + (size_t)row * DM, MEMB + (size_t)row * DM, RSTDM + row, lane);
    }
    GRID_SYNC();
    grid.sync();
    {
        pg8::Gemm g{XB, WT_IN, T, NPROJ, DM}; pg8::StaticOrder S; S.init(T, NPROJ, G, bid);
        pg8::EpiProj E{PROJ, RSTD0, ROPEA, ROPER};
        pg8::gemm_phase<pg8::EpiProj, pg8::StaticOrder, true, true>(lds, g, S, E);
    }
    GRID_SYNC();
    {
        u32x4 kv[4], vv[4]; bf16x8 qq[2];
        int p_, h_, c_, n_;
        attn_decode_a(slot, p_, h_, c_, n_);
        if (slot < 512) attn_load(kv, vv, qq, p_, xcd, h_, c_, n_, QA, KA, VA);
        for (int lu = slot; lu < 512; lu += nslot) {
            int np = 0, nh = 0, nc = 0, nn = 0; const bool has_next = lu + nslot < 512;
            if (has_next) attn_decode_a(lu + nslot, np, nh, nc, nn);
            attn_unit<false>(lds, kv, vv, qq, p_, xcd, h_, c_, n_, has_next, np, nh, nc, nn, QA, KA, VA, AO, AST, nullptr, nullptr);
            p_ = np; h_ = nh; c_ = nc; n_ = nn;
        }
    }
    for (int lu = 512 + slot; lu < 640; lu += nslot) { const int v = lu - 512; ret_state_unit(lds, xcd, v >> 5, v & 31, KR, VR, KVT); }
    GRID_SYNC();
    {
        for (int it = slot * 512 + tid; it < 4 * 4096; it += nslot * 512) {
            const int bh = xcd * 4 + (it >> 12), off = (it & 4095) * 4;
            const float dec = fast_exp2(128.0f * ret_log2g(bh & 3));
            f32x4 R = {0.f, 0.f, 0.f, 0.f};
            for (int c0 = 0; c0 < 32; c0 += 8) {
                f32x4 kv[8];
#pragma unroll
                for (int c = 0; c < 8; ++c) kv[c] = *(const f32x4*)(KVT + ((size_t)bh * 32 + c0 + c) * 16384 + off);
#pragma unroll
                for (int c = 0; c < 8; ++c) {
                    u32x2 wv; wv.x = cvt_pk_bf16(R[0], R[1]); wv.y = cvt_pk_bf16(R[2], R[3]);
                    *(u32x2*)(RB + ((size_t)bh * 32 + c0 + c) * 16384 + off) = wv;
                    R = R * dec + kv[c];
                }
            }
        }
    }
    {
        pg8::Gemm g{MEMB, WT_KV, MROWS, 2 * DM, DM}; pg8::StaticOrder S; S.init(MROWS, 2 * DM, G, bid);
        pg8::EpiScale E{MEMKV, 2 * DM, RSTDM, 1.0f};
        pg8::gemm_phase<pg8::EpiScale, pg8::StaticOrder, true, true>(lds, g, S, E);
    }
    {
        const bool uneven = (nslot == 32);
        const int first = !uneven ? slot : (slot >= 8 ? slot - 8 : 216 + slot), stride = !uneven ? nslot : (slot >= 8 ? 24 : 8);
        const int last = !uneven ? 256 : (slot >= 8 ? 216 : 256);
        u32x4 kv[4], vv[4]; bf16x8 qq[2];
        if (first < last) attn_load(kv, vv, qq, 2, xcd, first >> 5, (first & 31) >> 1, first & 1, QA, KA, VA);
        for (int lu = first; lu < last; lu += stride) {
            const int ln = lu + stride; const bool has_next = ln < last;
            attn_unit<true>(lds, kv, vv, qq, 2, xcd, lu >> 5, (lu & 31) >> 1, lu & 1, has_next, 2, ln >> 5, (ln & 31) >> 1, ln & 1, QA, KA, VA, AO, AST, P.in[5], YMIX);
        }
    }
    GRID_SYNC();
    for (int lu = slot; lu < 128; lu += nslot) ret_out_unit(lds, xcd, lu >> 5, lu & 31, QR, KR, VR, GR, RB, P.in[6], YMIX);
    __syncthreads();
    GRID_SYNC();
    {
        pg8::Gemm g{YMIX, WT_OUT, T, DM, DM}; pg8::StaticOrder S; S.init(T, DM, G, bid);
        pg8::EpiYss E{YOUT, SS1};
        pg8::gemm_phase<pg8::EpiYss, pg8::StaticOrder, true, true>(lds, g, S, E);
    }
    GRID_SYNC();
    residual_pass<false>(XB, YOUT, SS1, P.in[3], nullptr, RSTD1);
    GRID_SYNC();
    {
        pg8::Gemm g{XB, WT_Q, T, DM, DM}; pg8::StaticOrder S; S.init(T, DM, G, bid);
        pg8::EpiScale E{QX, DM, RSTD1, 0.0625f * LOG2E};
        pg8::gemm_phase<pg8::EpiScale, pg8::StaticOrder, true, true>(lds, g, S, E);
    }
    GRID_SYNC();
    {
        u32x4 pv[4], pw[4]; bf16x8 qn[8];
        if (slot < 128) { const bf16_t* k0 = MEMKV + (size_t)(xcd * NMEM) * 2048 + (slot >> 5) * 256; xs_load(pv, k0); xs_load(pw, k0 + 64); xattn_qload(qn, xcd, slot >> 5, slot & 31, QX); }
        for (int lu = slot; lu < 128; lu += nslot) {
            const int ln = lu + nslot;
            xattn_unit(lds, pv, pw, qn, xcd, lu >> 5, lu & 31, ln < 128, ln >> 5, ln & 31, QX, MEMKV, OX);
        }
    }
    __syncthreads();
    GRID_SYNC();
    {
        pg8::Gemm g{OX, WT_O, T, DM, DM}; pg8::StaticOrder S; S.init(T, DM, G, bid);
        pg8::EpiYss E{YOUT, SS2};
        pg8::gemm_phase<pg8::EpiYss, pg8::StaticOrder, true, true>(lds, g, S, E);
    }
    GRID_SYNC();
    residual_pass<false>(XB, YOUT, SS2, P.in[9], nullptr, RSTD2);
    GRID_SYNC();
    {
        pg8::Gemm g{XB, WT_GU, T, 2 * FFH, DM}; pg8::StaticOrder S; S.init(T, 2 * FFH, G, bid);
        pg8::EpiSwiGLU E{HFF, RSTD2};
        pg8::gemm_phase<pg8::EpiSwiGLU, pg8::StaticOrder, true, true>(lds, g, S, E);
    }
    GRID_SYNC();
    {
        pg8::Gemm g{HFF, WT_DN, T, DM, FFH}; pg8::StaticOrder S; S.init(T, DM, G, bid);
        pg8::EpiYss E{YOUT, SS3};
        pg8::gemm_phase<pg8::EpiYss, pg8::StaticOrder, true, true>(lds, g, S, E);
    }
    GRID_SYNC();
    residual_pass<true>(XB, YOUT, SS3, P.in[15], P.out, nullptr);
}

extern "C" void kernel_launch(void* const* d_in, const int* in_sizes, int n_in, void* d_out, int out_size, void* d_ws, size_t ws_size, hipStream_t stream) {
    static int grid = 0;
    if (grid == 0) {
        if (n_in != 18 || ws_size < WS_END) { fprintf(stderr, "kernel_launch: unexpected problem (n_in %d, ws %zu)\n", n_in, ws_size); grid = -1; return; }
        int dev = 0, cus = 0, per_cu = 0;
        hipGetDevice(&dev);
        hipDeviceGetAttribute(&cus, hipDeviceAttributeMultiprocessorCount, dev);
        if (hipFuncSetAttribute((const void*)hymba_fwd, hipFuncAttributeMaxDynamicSharedMemorySize, LDS_BYTES) != hipSuccess) { fprintf(stderr, "kernel_launch: hipFuncSetAttribute failed\n"); grid = -1; return; }
        if (hipOccupancyMaxActiveBlocksPerMultiprocessor(&per_cu, (const void*)hymba_fwd, 512, LDS_BYTES) != hipSuccess || per_cu < 1) { fprintf(stderr, "kernel_launch: occupancy query failed (%d)\n", per_cu); (void)hipGetLastError(); grid = -1; return; }
        grid = cus * 1;
        if (grid < 8 || (grid & 7) != 0) { fprintf(stderr, "kernel_launch: the batch-affine work mapping needs a grid that is a multiple of 8 (got %d); nothing launched\n", grid); grid = -1; return; }
    }
    if (grid < 0) return;
    Params p{};
    for (int i = 0; i < 18; ++i) p.in[i] = (const float*)d_in[i];
    p.out = (float*)d_out; p.ws = (unsigned char*)d_ws;
    for (int i = 0; i < 8; ++i) p.inv_att[i] = powf(500000.0f, -((float)(2 * i) / 16.0f));
    for (int i = 0; i < 64; ++i) p.inv_ret[i] = powf(10000.0f, -((float)(2 * i) / 128.0f));
    if (hipMemsetAsync(d_ws, 0, 16384, stream) != hipSuccess) { fprintf(stderr, "kernel_launch: memset of the barrier word failed\n"); return; }
    void* args[] = {&p};
    hipError_t e = hipLaunchCooperativeKernel((const void*)hymba_fwd, dim3(grid), dim3(512), args, LDS_BYTES, stream);
    if (e != hipSuccess) fprintf(stderr, "kernel_launch: cooperative launch failed: %s (grid %d)\n", hipGetErrorString(e), grid);
}
```

```cpp
#include <hip/hip_runtime.h>
#include <hip/hip_cooperative_groups.h>
#include <cstdio>
#include <cstdint>
#include <cmath>
namespace cg = cooperative_groups;
namespace pg8 {
#define PG8_LAS __attribute__((address_space(3)))
typedef unsigned short bf16_t;
typedef short bf16x8 __attribute__((ext_vector_type(8)));
typedef float f32x4 __attribute__((ext_vector_type(4)));
typedef unsigned u32x4 __attribute__((ext_vector_type(4)));
constexpr int BM = 256, BK = 64, HALF = 128, HTB = HALF * BK * 2  , STAGE_BYTES = 8 * HTB, NXCD = 8, WGM = 8;

__host__ __device__ __forceinline__ int lds_byte(int r, int c) { const int st = (r >> 4) * 2 + (c >> 5), rr = r & 15, cc = c & 31, ob = rr * 64 + cc * 2; return st * 1024 + (ob ^ (((ob >> 9) & 1) << 5)); }
__host__ __device__ __forceinline__ void stage_rc(int b, int& R, int& C) { const int st = b / 1024, sb = b % 1024, swz = sb ^ (((sb >> 9) & 1) << 5); R = (st >> 1) * 16 + swz / 64; C = (st & 1) * 32 + (swz % 64) / 2; }
__host__ __device__ __forceinline__ int perm32(int rho) { const int n = rho >> 4, i = rho & 15; return 8 * (i >> 2) + 4 * n + (i & 3); }

struct Unit { int pm, pn; };
struct Gemm { const bf16_t* A; const bf16_t* Bt; int M, N, K; };

struct StaticOrder {
    int nM, nN, nwg, G, c;
    __host__ __device__ void init(int M, int N, int G_, int c_) { nM = M / BM; nN = N / BM; nwg = nM * nN; G = G_; c = c_; }
    __host__ __device__ bool next(int i, Unit& u) const {
        const long L = (long)i * G + c; if (L >= nwg) return false;
        int wgid = (int)L; { const int q = nwg / NXCD, r = nwg % NXCD, xcd = wgid % NXCD, off = wgid / NXCD; wgid = (xcd < r ? xcd * (q + 1) : r * (q + 1) + (xcd - r) * q) + off; }
        const int nig = WGM * nN, gid = wgid / nig, fm = gid * WGM, gsz = (nM - fm) < WGM ? (nM - fm) : WGM;
        u.pm = fm + ((wgid % nig) % gsz); u.pn = (wgid % nig) / gsz; return true;
    }
    __device__ __forceinline__ void a_ready(const Unit&) const {}
    __device__ __forceinline__ void done(const Unit&) const {}
};
__device__ __forceinline__ unsigned cvt_pk_bf16(float lo, float hi) { unsigned r; asm volatile("v_cvt_pk_bf16_f32 %0, %1, %2" : "=v"(r) : "v"(lo), "v"(hi)); return r; }
template <class Epi, class Sched, bool ALIGN_EPI = false, bool SP2 = false>
__device__ __forceinline__ void gemm_phase(PG8_LAS unsigned char* lds, const Gemm g, const Sched& S, const Epi& E) {
    const int tid = threadIdx.x, wid = __builtin_amdgcn_readfirstlane(tid >> 6), lane = tid & 63, wr = wid >> 2, wc = wid & 3, fr = lane & 15, fq = lane >> 4;
    const int K = g.K, nt = K / BK;
    unsigned voffA[2], voffB[2];
#pragma unroll
    for (int i = 0; i < 2; ++i) { int R, C; stage_rc(tid * 16 + i * 8192, R, C); const int Rb = Epi::PERM ? ((R & ~31) + perm32(R & 31)) : R;
        voffA[i] = (unsigned)(R * K + C) * 2u; voffB[i] = (unsigned)(Rb * K + C) * 2u; }
    const size_t kstep = (size_t)(BK * 2);
    const size_t hstep = (size_t)HALF * K * 2;
    const size_t tstep = 2 * hstep;
    const unsigned ldsw = (unsigned)wid * 1024u;
    const int aoff = lds_byte(wr * 64 + fr, fq * 8), boff = lds_byte(wc * 32 + fr, fq * 8);
#define PG8_SA(b, h) (((b) * 2 + (h)) * HTB)
#define PG8_SB(b, h) ((4 + (b) * 2 + (h)) * HTB)
#define PG8_STAGE(bufoff, gbase, voff) do { _Pragma("unroll") for (int _i = 0; _i < 2; ++_i) \
        __builtin_amdgcn_global_load_lds((const unsigned*)((const char*)(gbase) + (voff)[_i]), (PG8_LAS unsigned*)(lds + (bufoff) + ldsw + _i * 8192), 16, 0, 0); } while (0)
#define PG8_LDA(dst, b, h) do { _Pragma("unroll") for (int m = 0; m < 4; ++m) _Pragma("unroll") for (int k = 0; k < 2; ++k) dst[m][k] = *(const PG8_LAS bf16x8*)(lds + PG8_SA(b, h) + aoff + m * 2048 + k * 1024); } while (0)
#define PG8_LDB(dst, b, h) do { _Pragma("unroll") for (int n = 0; n < 2; ++n) _Pragma("unroll") for (int k = 0; k < 2; ++k) dst[n][k] = *(const PG8_LAS bf16x8*)(lds + PG8_SB(b, h) + boff + n * 2048 + k * 1024); } while (0)
#define PG8_MMA(ai, bj, At, Bt) do { __builtin_amdgcn_s_setprio(1); _Pragma("unroll") for (int m = 0; m < 4; ++m) _Pragma("unroll") for (int n = 0; n < 2; ++n) _Pragma("unroll") for (int k = 0; k < 2; ++k) \
        acc[ai][bj][m][n] = __builtin_amdgcn_mfma_f32_16x16x32_bf16(Bt[n][k], At[m][k], acc[ai][bj][m][n], 0, 0, 0); __builtin_amdgcn_s_setprio(0); } while (0)
#define PG8_WAIT_V(n) asm volatile("s_waitcnt vmcnt(" #n ")" ::: "memory")
#define PG8_WAIT_L(n) asm volatile("s_waitcnt lgkmcnt(" #n ")" ::: "memory")
#define PG8_BAR __builtin_amdgcn_s_barrier()
#define PG8_SCHED __builtin_amdgcn_sched_barrier(0)
    Unit cur, nxt; int ui = 0;
    if (!S.next(0, cur)) return;
    f32x4 acc[2][2][4][2];
#pragma unroll
    for (int a = 0; a < 2; ++a)
#pragma unroll
        for (int b = 0; b < 2; ++b)
#pragma unroll
            for (int m = 0; m < 4; ++m)
#pragma unroll
                for (int n = 0; n < 2; ++n) acc[a][b][m][n] = (f32x4){0.f, 0.f, 0.f, 0.f};
    bf16x8 At[4][2], B0[2][2], B1[2][2];
    const char* cA = (const char*)g.A + (size_t)cur.pm * tstep; const char* cB = (const char*)g.Bt + (size_t)cur.pn * tstep;
    S.a_ready(cur);
    if constexpr (SP2) {
        PG8_STAGE(PG8_SB(0, 0), cB, voffB); PG8_STAGE(PG8_SB(0, 1), cB + hstep, voffB); PG8_STAGE(PG8_SA(0, 0), cA, voffA); PG8_STAGE(PG8_SA(0, 1), cA + hstep, voffA);
        if (wr == 1) PG8_BAR;
        PG8_WAIT_V(2); PG8_BAR;
        PG8_STAGE(PG8_SB(1, 0), cB + kstep, voffB); PG8_STAGE(PG8_SA(1, 0), cA + kstep, voffA); PG8_STAGE(PG8_SB(1, 1), cB + hstep + kstep, voffB);
        PG8_WAIT_V(6); PG8_BAR;
    } else {
        PG8_STAGE(PG8_SB(0, 0), cB, voffB); PG8_STAGE(PG8_SA(0, 0), cA, voffA); PG8_STAGE(PG8_SB(0, 1), cB + hstep, voffB); PG8_STAGE(PG8_SA(0, 1), cA + hstep, voffA);
        if (wr == 1) PG8_BAR;
        PG8_WAIT_V(4); PG8_BAR;
        PG8_STAGE(PG8_SB(1, 0), cB + kstep, voffB); PG8_STAGE(PG8_SA(1, 0), cA + kstep, voffA); PG8_STAGE(PG8_SB(1, 1), cB + hstep + kstep, voffB);
        PG8_WAIT_V(6); PG8_BAR;
    }
    for (;;) {
        const bool has_next = S.next(ui + 1, nxt);
        const char* nA = has_next ? (const char*)g.A + (size_t)nxt.pm * tstep : cA; const char* nB = has_next ? (const char*)g.Bt + (size_t)nxt.pn * tstep : cB;
        for (int t = 0; t < nt; t += 2) {
            const bool last = (t == nt - 2);
            const char* a1 = cA + (size_t)(t + 1) * kstep;
            const char* a2 = last ? nA : cA + (size_t)(t + 2) * kstep; const char* b2 = last ? nB : cB + (size_t)(t + 2) * kstep;
            const char* a3 = a2 + kstep; const char* b3 = b2 + kstep;
            if (last && has_next) S.a_ready(nxt);
            if constexpr (SP2) {
            PG8_LDB(B0, 0, 0); PG8_LDB(B1, 0, 1); PG8_SCHED; PG8_LDA(At, 0, 0); PG8_STAGE(PG8_SA(1, 1), a1 + hstep, voffA);
            PG8_WAIT_V(8); PG8_WAIT_L(0); PG8_BAR; PG8_MMA(0, 0, At, B0); PG8_MMA(0, 1, At, B1); PG8_BAR; PG8_SCHED;
            PG8_LDA(At, 0, 1); PG8_STAGE(PG8_SB(0, 0), b2, voffB); PG8_STAGE(PG8_SB(0, 1), b2 + hstep, voffB); PG8_STAGE(PG8_SA(0, 0), a2, voffA);
            PG8_WAIT_V(8); PG8_WAIT_L(0); PG8_BAR; PG8_MMA(1, 0, At, B0); PG8_MMA(1, 1, At, B1); PG8_BAR; PG8_SCHED;
            PG8_LDB(B0, 1, 0); PG8_LDB(B1, 1, 1); PG8_SCHED; PG8_LDA(At, 1, 0); PG8_STAGE(PG8_SA(0, 1), a2 + hstep, voffA);
            PG8_WAIT_V(8); PG8_WAIT_L(0); PG8_BAR; PG8_MMA(0, 0, At, B0); PG8_MMA(0, 1, At, B1); PG8_BAR; PG8_SCHED;
            PG8_LDA(At, 1, 1); PG8_STAGE(PG8_SB(1, 0), b3, voffB); PG8_STAGE(PG8_SB(1, 1), b3 + hstep, voffB); PG8_STAGE(PG8_SA(1, 0), a3, voffA);
            PG8_WAIT_V(8); PG8_WAIT_L(0); PG8_BAR; PG8_MMA(1, 0, At, B0); PG8_MMA(1, 1, At, B1); PG8_BAR; PG8_SCHED;
            } else {
            PG8_LDB(B0, 0, 0); PG8_SCHED; PG8_LDA(At, 0, 0); PG8_STAGE(PG8_SA(1, 1), a1 + hstep, voffA);
            PG8_WAIT_L(8); PG8_BAR; PG8_WAIT_L(0); PG8_MMA(0, 0, At, B0); PG8_BAR; PG8_SCHED;
            PG8_LDB(B1, 0, 1); PG8_STAGE(PG8_SB(0, 0), b2, voffB);
            PG8_BAR; PG8_WAIT_L(0); PG8_MMA(0, 1, At, B1); PG8_BAR;
            PG8_LDA(At, 0, 1); PG8_STAGE(PG8_SA(0, 0), a2, voffA);
            PG8_BAR; PG8_WAIT_L(0); PG8_MMA(1, 0, At, B0); PG8_BAR; PG8_SCHED;
            PG8_STAGE(PG8_SB(0, 1), b2 + hstep, voffB);
            PG8_WAIT_V(6); PG8_BAR; PG8_MMA(1, 1, At, B1); PG8_BAR;
            PG8_LDB(B0, 1, 0); PG8_SCHED; PG8_LDA(At, 1, 0); PG8_STAGE(PG8_SA(0, 1), a2 + hstep, voffA);
            PG8_WAIT_L(8); PG8_BAR; PG8_WAIT_L(0); PG8_MMA(0, 0, At, B0); PG8_BAR; PG8_SCHED;
            PG8_LDB(B1, 1, 1); PG8_STAGE(PG8_SB(1, 0), b3, voffB);
            PG8_BAR; PG8_WAIT_L(0); PG8_MMA(0, 1, At, B1); PG8_BAR;
            PG8_LDA(At, 1, 1); PG8_STAGE(PG8_SA(1, 0), a3, voffA);
            PG8_BAR; PG8_WAIT_L(0); PG8_MMA(1, 0, At, B0); PG8_BAR; PG8_SCHED;
            PG8_STAGE(PG8_SB(1, 1), b3 + hstep, voffB);
            PG8_WAIT_V(6); PG8_BAR; PG8_MMA(1, 1, At, B1); PG8_BAR;
            }
        }
        if constexpr (ALIGN_EPI) { if (wr == 0) PG8_BAR; }
        if constexpr (!Epi::AFTER_DRAIN) { E(acc, cur, wr, wc, fr, fq); S.done(cur); }
        if (!has_next) break;
#pragma unroll
        for (int a = 0; a < 2; ++a)
#pragma unroll
            for (int b = 0; b < 2; ++b)
#pragma unroll
                for (int m = 0; m < 4; ++m)
#pragma unroll
                    for (int n = 0; n < 2; ++n) acc[a][b][m][n] = (f32x4){0.f, 0.f, 0.f, 0.f};
        cur = nxt; cA = nA; cB = nB; ++ui;
        if constexpr (ALIGN_EPI) { if (wr == 1) PG8_BAR; }
    }
    PG8_WAIT_V(0);
    if constexpr (!ALIGN_EPI) { if (wr == 0) PG8_BAR; }
    PG8_BAR;
    if constexpr (Epi::AFTER_DRAIN) { E.fused(acc, cur, wr, wc, fr, fq, lds, wid, lane); S.done(cur); }
#undef PG8_SA
#undef PG8_SB
#undef PG8_STAGE
#undef PG8_LDA
#undef PG8_LDB
#undef PG8_MMA
#undef PG8_WAIT_V
#undef PG8_WAIT_L
#undef PG8_BAR
#undef PG8_SCHED
}
}
constexpr int NB = 8, SEQ = 4096, DM = 1024, T = NB * SEQ;
constexpr int NMEM = 256, MROWS = NB * NMEM;
constexpr int NPROJ = 3584, FFH = 2816;
constexpr float RMS_EPS = 1e-6f, GN_EPS = 1e-5f;
constexpr float LOG2E = 1.4426950408889634f;

typedef unsigned u32x4 __attribute__((ext_vector_type(4)));
typedef unsigned u32x2 __attribute__((ext_vector_type(2)));
typedef short s16x4 __attribute__((ext_vector_type(4)));
typedef float f32x2 __attribute__((ext_vector_type(2)));
using pg8::bf16_t; using pg8::bf16x8; using pg8::f32x4; using pg8::cvt_pk_bf16;
#define LAS __attribute__((address_space(3)))

__device__ __forceinline__ float bf_lo(unsigned w) { return __uint_as_float(w << 16); }
__device__ __forceinline__ float bf_hi(unsigned w) { return __uint_as_float(w & 0xffff0000u); }
__device__ __forceinline__ float wave_sum(float v) {
#pragma unroll
    for (int o = 1; o < 64; o <<= 1) v += __shfl_xor(v, o);
    return v;
}
__device__ __forceinline__ float fast_exp2(float x) { return __builtin_amdgcn_exp2f(x); }
__device__ __forceinline__ float max3_raw(float a, float b, float c) { float r; asm("v_max3_f32 %0, %1, %2, %3" : "=v"(r) : "v"(a), "v"(b), "v"(c)); return r; }
__device__ __forceinline__ float silu_f(float g) { return g * __builtin_amdgcn_rcpf(1.0f + __expf(-g)); }

namespace pg8 {
struct EpiProj {
    static constexpr bool PERM = true, AFTER_DRAIN = false;
    bf16_t* base; const float* rstd; const f32x2* ropeA; const f32x2* ropeR;
    __device__ __forceinline__ void operator()(const f32x4 (&acc)[2][2][4][2], const Unit& u, int wr, int wc, int fr, int fq) const {
        const int seg = u.pn >> 1;
        bf16_t* O = base + (size_t)seg * ((size_t)T * 512);
        const int c0 = (u.pn & 1) * 256 + wc * 32 + 8 * fq;
        const bool ropeAtt = (seg <= 1) && ((wc & 1) == 0) && (fq < 2);
        const bool ropeRet = (seg == 3) || (seg == 4);
        const float segscale = (seg == 0) ? (0.125f * LOG2E) : ((seg == 4) ? 0.08838834764831845f : 1.0f);
#pragma unroll
        for (int ai = 0; ai < 2; ++ai)
#pragma unroll
            for (int m = 0; m < 4; ++m) {
                const int row = u.pm * BM + ai * HALF + wr * 64 + m * 16 + fr;
                const int pos = row & (SEQ - 1);
                const float rs = rstd[row] * segscale;
#pragma unroll
                for (int bj = 0; bj < 2; ++bj) {
                    const int col = c0 + bj * HALF;
                    f32x4 v0 = acc[ai][bj][m][0] * rs, v1 = acc[ai][bj][m][1] * rs;
                    if (ropeAtt || ropeRet) {
                        const f32x2* tb = ropeRet ? (ropeR + (size_t)pos * 64 + ((col & 127) >> 1)) : (ropeA + (size_t)pos * 8 + ((col & 15) >> 1));
                        const f32x2 t0 = tb[0], t1 = tb[1], t2 = tb[2], t3 = tb[3];
                        f32x4 w0, w1;
                        w0[0] = v0[0] * t0.x - v0[1] * t0.y; w0[1] = v0[1] * t0.x + v0[0] * t0.y;
                        w0[2] = v0[2] * t1.x - v0[3] * t1.y; w0[3] = v0[3] * t1.x + v0[2] * t1.y;
                        w1[0] = v1[0] * t2.x - v1[1] * t2.y; w1[1] = v1[1] * t2.x + v1[0] * t2.y;
                        w1[2] = v1[2] * t3.x - v1[3] * t3.y; w1[3] = v1[3] * t3.x + v1[2] * t3.y;
                        v0 = w0; v1 = w1;
                    }
                    u32x4 w; w.x = cvt_pk_bf16(v0[0], v0[1]); w.y = cvt_pk_bf16(v0[2], v0[3]); w.z = cvt_pk_bf16(v1[0], v1[1]); w.w = cvt_pk_bf16(v1[2], v1[3]);
                    *(u32x4*)(O + (size_t)row * 512 + col) = w;
                }
            }
    }
};
struct EpiScale {
    static constexpr bool PERM = true, AFTER_DRAIN = false;
    bf16_t* O; int ldc; const float* rstd; float scale;
    __device__ __forceinline__ void operator()(const f32x4 (&acc)[2][2][4][2], const Unit& u, int wr, int wc, int fr, int fq) const {
        const int c0 = u.pn * BM + wc * 32 + 8 * fq;
#pragma unroll
        for (int ai = 0; ai < 2; ++ai)
#pragma unroll
            for (int m = 0; m < 4; ++m) {
                const int row = u.pm * BM + ai * HALF + wr * 64 + m * 16 + fr;
                const float rs = rstd[row] * scale;
#pragma unroll
                for (int bj = 0; bj < 2; ++bj) {
                    const f32x4 v0 = acc[ai][bj][m][0] * rs, v1 = acc[ai][bj][m][1] * rs;
                    u32x4 w; w.x = cvt_pk_bf16(v0[0], v0[1]); w.y = cvt_pk_bf16(v0[2], v0[3]); w.z = cvt_pk_bf16(v1[0], v1[1]); w.w = cvt_pk_bf16(v1[2], v1[3]);
                    *(u32x4*)(O + (size_t)row * ldc + c0 + bj * HALF) = w;
                }
            }
    }
};
struct EpiYss {
    static constexpr bool PERM = true, AFTER_DRAIN = false;
    bf16_t* O; float* ss;
    __device__ __forceinline__ void operator()(const f32x4 (&acc)[2][2][4][2], const Unit& u, int wr, int wc, int fr, int fq) const {
        const int c0 = u.pn * BM + wc * 32 + 8 * fq;
#pragma unroll
        for (int ai = 0; ai < 2; ++ai)
#pragma unroll
            for (int m = 0; m < 4; ++m) {
                const int row = u.pm * BM + ai * HALF + wr * 64 + m * 16 + fr;
                float s = 0.f;
#pragma unroll
                for (int bj = 0; bj < 2; ++bj) {
                    const f32x4 v0 = acc[ai][bj][m][0], v1 = acc[ai][bj][m][1];
                    s += (v0[0] * v0[0] + v0[1] * v0[1]) + (v0[2] * v0[2] + v0[3] * v0[3]) + (v1[0] * v1[0] + v1[1] * v1[1]) + (v1[2] * v1[2] + v1[3] * v1[3]);
                    u32x4 w; w.x = cvt_pk_bf16(v0[0], v0[1]); w.y = cvt_pk_bf16(v0[2], v0[3]); w.z = cvt_pk_bf16(v1[0], v1[1]); w.w = cvt_pk_bf16(v1[2], v1[3]);
                    *(u32x4*)(O + (size_t)row * DM + c0 + bj * HALF) = w;
                }
                s += __shfl_xor(s, 16); s += __shfl_xor(s, 32);
                if (fq == 0) ss[((size_t)u.pn * T + row) * 4 + wc] = s;
            }
    }
};
struct EpiSwiGLU {
    static constexpr bool PERM = true, AFTER_DRAIN = false;
    bf16_t* O; const float* rstd;
    __device__ __forceinline__ void operator()(const f32x4 (&acc)[2][2][4][2], const Unit& u, int wr, int wc, int fr, int fq) const {
        const int c0 = u.pn * HALF + wc * 32 + 8 * fq;
#pragma unroll
        for (int ai = 0; ai < 2; ++ai)
#pragma unroll
            for (int m = 0; m < 4; ++m) {
                const int row = u.pm * BM + ai * HALF + wr * 64 + m * 16 + fr;
                const float rs = rstd[row];
                float h[8];
#pragma unroll
                for (int n = 0; n < 2; ++n)
#pragma unroll
                    for (int j = 0; j < 4; ++j) { const float g = acc[ai][0][m][n][j] * rs, up = acc[ai][1][m][n][j] * rs; h[n * 4 + j] = silu_f(g) * up; }
                u32x4 w; w.x = cvt_pk_bf16(h[0], h[1]); w.y = cvt_pk_bf16(h[2], h[3]); w.z = cvt_pk_bf16(h[4], h[5]); w.w = cvt_pk_bf16(h[6], h[7]);
                *(u32x4*)(O + (size_t)row * FFH + c0) = w;
            }
    }
};
}

constexpr size_t MiB = 1u << 20;
constexpr size_t WS_WT_IN = 1 * MiB, WS_WT_OUT = 8 * MiB, WS_WT_Q = 10 * MiB, WS_WT_KV = 12 * MiB, WS_WT_O = 16 * MiB, WS_WT_GU = 18 * MiB, WS_WT_DN = 29 * MiB;
constexpr size_t WS_ROPEA = 35 * MiB, WS_ROPER = 36 * MiB, WS_RSTD = 38 * MiB, WS_SS = 39 * MiB, WS_MEMB = 40 * MiB, WS_MEMKV = 44 * MiB, WS_AST = 52 * MiB;
constexpr size_t WS_XB = 56 * MiB, WS_KVT = 56 * MiB;
constexpr size_t WS_YOUT = 120 * MiB, WS_AO = 120 * MiB;
constexpr size_t WS_YMIX = 184 * MiB, WS_PROJ = 248 * MiB, WS_RB = 472 * MiB, WS_SSP = 504 * MiB, WS_END = 510 * MiB;
constexpr size_t SEGE = (size_t)T * 512;

struct Params {
    const float* in[18];
    float* out; unsigned char* ws;
    float inv_att[8]; float inv_ret[64];
    int pad[2];
};

constexpr int LDS_BYTES = 139264;

__device__ __forceinline__ unsigned f2bf(float f) { unsigned u = __builtin_bit_cast(unsigned, f); return (u + 0x7fffu + ((u >> 16) & 1u)) >> 16; }
__device__ __forceinline__ unsigned pk2(float lo, float hi) { return f2bf(lo) | (f2bf(hi) << 16); }

__device__ __forceinline__ int map_win(int n) {
    const int seg = n >> 9, w = n & 511;
    if (seg <= 1) { const int d = w & 63; const int nd = d < 8 ? 2 * d : (d < 16 ? 2 * (d - 8) + 1 : d); return (n & ~63) + nd; }
    if (seg == 3 || seg == 4) { const int d = w & 127; const int nd = d < 64 ? 2 * d : 2 * (d - 64) + 1; return (n & ~127) + nd; }
    return n;
}
__device__ __forceinline__ int map_gu(int n) { const int isu = n >= FFH ? 1 : 0; const int j = n - isu * FFH; return 256 * (j >> 7) + 128 * isu + (j & 127); }

template <int MAP>
__device__ __forceinline__ void transpose_item(const float* W, const float* gain, int K, int N, bf16_t* WT, LAS float* scr, int item, int lane) {
    const int nblk = N / 32, kb = item / nblk, nb = item % nblk, k0 = 64 * kb, n0 = 32 * nb;
#pragma unroll 16
    for (int i = 0; i < 32; ++i) { const int kk = 2 * i + (lane >> 5); const float g = gain ? gain[k0 + kk] : 1.0f; scr[kk * 33 + (lane & 31)] = __builtin_nontemporal_load(W + (size_t)(k0 + kk) * N + n0 + (lane & 31)) * g; }
    asm volatile("s_waitcnt lgkmcnt(0)" ::: "memory");
    const int c = lane & 7;
#pragma unroll
    for (int j = 0; j < 4; ++j) { const int n = (lane >> 3) + 8 * j; const LAS float* s = scr + (8 * c) * 33 + n;
        u32x4 o; o.x = pk2(s[0 * 33], s[1 * 33]); o.y = pk2(s[2 * 33], s[3 * 33]); o.z = pk2(s[4 * 33], s[5 * 33]); o.w = pk2(s[6 * 33], s[7 * 33]);
        const int nn = n0 + n; const int dr = MAP == 1 ? map_win(nn) : (MAP == 2 ? map_gu(nn) : nn);
        *(u32x4*)(WT + (size_t)dr * K + k0 + 8 * c) = o; }
    asm volatile("s_waitcnt lgkmcnt(0)" ::: "memory");
}

__device__ __forceinline__ void row_to_bf16(const float* xrow, bf16_t* orow, float* rstd_out, int lane) {
    const f32x4* xr = (const f32x4*)xrow + lane;
    f32x4 v[4]; float s = 0.f;
#pragma unroll
    for (int j = 0; j < 4; ++j) { v[j] = xr[64 * j]; s += (v[j][0] * v[j][0] + v[j][1] * v[j][1]) + (v[j][2] * v[j][2] + v[j][3] * v[j][3]); }
    s = wave_sum(s);
    u32x2* o8 = (u32x2*)orow + lane;
#pragma unroll
    for (int j = 0; j < 4; ++j) { u32x2 w; w.x = cvt_pk_bf16(v[j][0], v[j][1]); w.y = cvt_pk_bf16(v[j][2], v[j][3]); o8[64 * j] = w; }
    if (lane == 0) *rstd_out = 1.0f / sqrtf(s * (1.0f / DM) + RMS_EPS);
}

template <bool FINAL>
__device__ __forceinline__ void residual_pass(bf16_t* xb, const bf16_t* y, const float* ss, const float* g, float* xout, float* rstd_out) {
    const int bid = blockIdx.x, nblk = gridDim.x, lane = threadIdx.x & 63, wave = __builtin_amdgcn_readfirstlane(threadIdx.x >> 6);
    f32x4 gv[4];
#pragma unroll
    for (int j = 0; j < 4; ++j) gv[j] = ((const f32x4*)g)[lane + 64 * j];
    for (int ch = bid >> 3; ch < SEQ / 32; ch += nblk >> 3)
    for (int row = (bid & 7) * SEQ + ch * 32 + wave; row < (bid & 7) * SEQ + ch * 32 + 32; row += 8) {
        u32x2* xr = (u32x2*)(xb + (size_t)row * DM) + lane;
        const u32x2* yr = (const u32x2*)(y + (size_t)row * DM) + lane;
        float sq = ss[((size_t)((lane >> 2) & 3) * T + row) * 4 + (lane & 3)];
        sq += __shfl_xor(sq, 1); sq += __shfl_xor(sq, 2); sq += __shfl_xor(sq, 4); sq += __shfl_xor(sq, 8);
        const float r = 1.0f / sqrtf(sq * (1.0f / DM) + RMS_EPS);
        f32x4 v[4]; float s = 0.f;
#pragma unroll
        for (int j = 0; j < 4; ++j) {
            const u32x2 xw = xr[64 * j], yw = yr[64 * j];
            f32x4 xv, yv; xv[0] = bf_lo(xw.x); xv[1] = bf_hi(xw.x); xv[2] = bf_lo(xw.y); xv[3] = bf_hi(xw.y);
            yv[0] = bf_lo(yw.x); yv[1] = bf_hi(yw.x); yv[2] = bf_lo(yw.y); yv[3] = bf_hi(yw.y);
            v[j] = xv + yv * r * gv[j];
            s += (v[j][0] * v[j][0] + v[j][1] * v[j][1]) + (v[j][2] * v[j][2] + v[j][3] * v[j][3]);
        }
        if (FINAL) {
            f32x4* orow = (f32x4*)(xout + (size_t)row * DM) + lane;
#pragma unroll
            for (int j = 0; j < 4; ++j) __builtin_nontemporal_store(v[j], orow + 64 * j);
        } else {
            s = wave_sum(s);
#pragma unroll
            for (int j = 0; j < 4; ++j) { u32x2 w; w.x = cvt_pk_bf16(v[j][0], v[j][1]); w.y = cvt_pk_bf16(v[j][2], v[j][3]); xr[64 * j] = w; }
            if (lane == 0) rstd_out[row] = 1.0f / sqrtf(s * (1.0f / DM) + RMS_EPS);
        }
    }
}

__device__ __forceinline__ void rows2_to_bf16(const float* x0, const float* x1, bf16_t* o0, bf16_t* o1, float* r0, float* r1, int lane) {
    const f32x4* xa = (const f32x4*)x0 + lane; const f32x4* xb_ = (const f32x4*)x1 + lane;
    f32x4 va[4], vb[4]; float sa = 0.f, sb = 0.f;
#pragma unroll
    for (int j = 0; j < 4; ++j) { va[j] = __builtin_nontemporal_load(xa + 64 * j); vb[j] = __builtin_nontemporal_load(xb_ + 64 * j); }
#pragma unroll
    for (int j = 0; j < 4; ++j) { sa += (va[j][0] * va[j][0] + va[j][1] * va[j][1]) + (va[j][2] * va[j][2] + va[j][3] * va[j][3]); sb += (vb[j][0] * vb[j][0] + vb[j][1] * vb[j][1]) + (vb[j][2] * vb[j][2] + vb[j][3] * vb[j][3]); }
    sa = wave_sum(sa); sb = wave_sum(sb);
    u32x2* pa = (u32x2*)o0 + lane; u32x2* pb = (u32x2*)o1 + lane;
#pragma unroll
    for (int j = 0; j < 4; ++j) { u32x2 w; w.x = cvt_pk_bf16(va[j][0], va[j][1]); w.y = cvt_pk_bf16(va[j][2], va[j][3]); pa[64 * j] = w; w.x = cvt_pk_bf16(vb[j][0], vb[j][1]); w.y = cvt_pk_bf16(vb[j][2], vb[j][3]); pb[64 * j] = w; }
    if (lane == 0) { *r0 = 1.0f / sqrtf(sa * (1.0f / DM) + RMS_EPS); *r1 = 1.0f / sqrtf(sb * (1.0f / DM) + RMS_EPS); }
}

__device__ __forceinline__ f32x4 mfma16(bf16x8 a, bf16x8 b, f32x4 c) { return __builtin_amdgcn_mfma_f32_16x16x32_bf16(a, b, c, 0, 0, 0); }
__device__ __forceinline__ s16x4 tr_read(const LAS unsigned char* p) { return __builtin_bit_cast(s16x4, __builtin_amdgcn_ds_read_tr16_b64_v4i16((LAS s16x4*)p)); }
__device__ __forceinline__ bf16x8 tr_pair(const LAS unsigned char* p, int hi_off) {
    const s16x4 lo = tr_read(p), hi = tr_read(p + hi_off);
    return (bf16x8){lo[0], lo[1], lo[2], lo[3], hi[0], hi[1], hi[2], hi[3]};
}
typedef __bf16 bf16x2_t __attribute__((ext_vector_type(2)));
__device__ __forceinline__ unsigned cvtpk_c(float lo, float hi) { const f32x2 v = {lo, hi}; const bf16x2_t b = __builtin_convertvector(v, bf16x2_t); return __builtin_bit_cast(unsigned, b); }
__device__ __forceinline__ bf16x8 pack8(const f32x4 a, const f32x4 b) {
    u32x4 w; w.x = cvtpk_c(a[0], a[1]); w.y = cvtpk_c(a[2], a[3]); w.z = cvtpk_c(b[0], b[1]); w.w = cvtpk_c(b[2], b[3]);
    return __builtin_bit_cast(bf16x8, w);
}
__device__ __forceinline__ u32x4 scale8(u32x4 v, float s) {
    u32x4 o;
    o.x = cvtpk_c(bf_lo(v.x) * s, bf_hi(v.x) * s); o.y = cvtpk_c(bf_lo(v.y) * s, bf_hi(v.y) * s);
    o.z = cvtpk_c(bf_lo(v.z) * s, bf_hi(v.z) * s); o.w = cvtpk_c(bf_lo(v.w) * s, bf_hi(v.w) * s);
    return o;
}

constexpr int AT_STRIDE = 144;
constexpr int AT_KOFF = 0, AT_VOFF = 288 * AT_STRIDE;
__device__ __forceinline__ void attn_load(u32x4 (&kv)[4], u32x4 (&vv)[4], bf16x8 (&qq)[2], int p, int b, int h, int c, int n, const bf16_t* QA, const bf16_t* KA, const bf16_t* VA) {
    const int tid = threadIdx.x, r = 1 << (2 * p);
    { const int lane = tid & 63, w = tid >> 6; const size_t qrow = (size_t)(b * SEQ + c + r * (128 * n + 16 * w + (lane & 15)));
      qq[0] = *(const bf16x8*)(QA + qrow * 512 + h * 64 + 8 * (lane >> 4)); qq[1] = *(const bf16x8*)(QA + qrow * 512 + h * 64 + 32 + 8 * (lane >> 4)); }
#pragma unroll
    for (int it = 0; it < 4; ++it) {
        const int idx = tid + 512 * it, row = idx >> 3, pc = idx & 7;
        const int uk = 128 * (n - 1) + row;
        kv[it] = (u32x4){0u, 0u, 0u, 0u}; vv[it] = (u32x4){0u, 0u, 0u, 0u};
        if (uk >= 0) {
            const size_t g = ((size_t)(b * SEQ + c + r * uk)) * 512 + h * 64 + pc * 8;
            kv[it] = *(const u32x4*)(KA + g); vv[it] = *(const u32x4*)(VA + g);
        }
    }
}
template <bool MERGE>
__device__ __forceinline__ void attn_unit(LAS unsigned char* lds, u32x4 (&kv)[4], u32x4 (&vv)[4], bf16x8 (&qq)[2], int p, int b, int h, int c, int n,
                                          bool has_next, int np, int nh, int nc, int nn,
                                          const bf16_t* QA, const bf16_t* KA, const bf16_t* VA,
                                          bf16_t* AO, f32x2* AST, const float* gn_g, bf16_t* YMIX) {
    const int tid = threadIdx.x, lane = tid & 63, w = __builtin_amdgcn_readfirstlane(tid >> 6), fr = lane & 15, fq = lane >> 4;
    const int r = 1 << (2 * p);
    __syncthreads();
    {
#pragma unroll
        for (int it = 0; it < 4; ++it) {
            const int idx = tid + 512 * it, row = idx >> 3, pc = idx & 7;
            *(LAS u32x4*)(lds + AT_KOFF + row * AT_STRIDE + pc * 16) = kv[it];
            *(LAS u32x4*)(lds + AT_VOFF + row * AT_STRIDE + pc * 16) = vv[it];
        }
        if (tid < 256) { const int row = 256 + (tid >> 3), pc = tid & 7;
            *(LAS u32x4*)(lds + AT_KOFF + row * AT_STRIDE + pc * 16) = (u32x4){0u, 0u, 0u, 0u};
            *(LAS u32x4*)(lds + AT_VOFF + row * AT_STRIDE + pc * 16) = (u32x4){0u, 0u, 0u, 0u}; }
    }
    const int i = 16 * w + fr;
    const size_t qrow = (size_t)(b * SEQ + c + r * (128 * n + i));
    const bf16x8 q0 = qq[0], q1 = qq[1];
    if (has_next) attn_load(kv, vv, qq, np, b, nh, nc, nn, QA, KA, VA);
    f32x2 s0 = {0.f, 0.f}, s1 = {0.f, 0.f}; u32x2 x0[4], x1[4];
    if (MERGE) {
        const size_t sti = (size_t)(b * 8 + h) * SEQ + (qrow - (size_t)b * SEQ);
        s0 = AST[sti]; s1 = AST[(size_t)64 * SEQ + sti];
        const bf16_t* a0 = AO + qrow * 512 + h * 64 + 4 * fq; const bf16_t* a1 = a0 + SEGE;
#pragma unroll
        for (int dt = 0; dt < 4; ++dt) { x0[dt] = *(const u32x2*)(a0 + 16 * dt); x1[dt] = *(const u32x2*)(a1 + 16 * dt); }
    }
    __syncthreads();
    f32x4 sa[5], sb[5];
#pragma unroll
    for (int g = 0; g < 5; ++g) {
        const int rowa = 16 * w + 32 * g + 8 * (fr >> 2) + (fr & 3);
        const LAS unsigned char* ka = lds + AT_KOFF + rowa * AT_STRIDE + fq * 16;
        const bf16x8 ka0 = *(const LAS bf16x8*)(ka), ka1 = *(const LAS bf16x8*)(ka + 64);
        const bf16x8 kb0 = *(const LAS bf16x8*)(ka + 4 * AT_STRIDE), kb1 = *(const LAS bf16x8*)(ka + 4 * AT_STRIDE + 64);
        f32x4 z = {0.f, 0.f, 0.f, 0.f};
        sa[g] = mfma16(ka0, q0, z); sa[g] = mfma16(ka1, q1, sa[g]);
        sb[g] = mfma16(kb0, q0, z); sb[g] = mfma16(kb1, q1, sb[g]);
    }
#pragma unroll
    for (int j = 0; j < 4; ++j) {
        const int da = 8 * fq + j - fr, db = da + 4;
        sa[0][j] += (da < 0) ? -1e30f : 0.f; sb[0][j] += (db < 0) ? -1e30f : 0.f;
        sa[4][j] += (da > 0) ? -1e30f : 0.f; sb[4][j] += (db > 0) ? -1e30f : 0.f;
    }
    if (n == 0) {
#pragma unroll
        for (int g = 0; g < 5; ++g)
#pragma unroll
            for (int j = 0; j < 4; ++j) {
                const int ka_ = 16 * w + 32 * g + 8 * fq + j;
                sa[g][j] = (ka_ >= 128) ? sa[g][j] : -1e30f; sb[g][j] = (ka_ + 4 >= 128) ? sb[g][j] : -1e30f;
            }
    }
    float mx = -1e30f;
#pragma unroll
    for (int g = 0; g < 5; ++g)
#pragma unroll
        for (int j = 0; j < 4; ++j) mx = max3_raw(mx, sa[g][j], sb[g][j]);
    mx = fmaxf(mx, __shfl_xor(mx, 16)); mx = fmaxf(mx, __shfl_xor(mx, 32));
    const f32x4 mx4 = {mx, mx, mx, mx};
    f32x4 l4 = {0.f, 0.f, 0.f, 0.f};
#pragma unroll
    for (int g = 0; g < 5; ++g) {
        sa[g] = sa[g] - mx4; sb[g] = sb[g] - mx4;
#pragma unroll
        for (int j = 0; j < 4; ++j) { sa[g][j] = fast_exp2(sa[g][j]); sb[g][j] = fast_exp2(sb[g][j]); }
        l4 = l4 + sa[g]; l4 = l4 + sb[g];
    }
    float l = (l4[0] + l4[1]) + (l4[2] + l4[3]);
    l += __shfl_xor(l, 16); l += __shfl_xor(l, 32);
    f32x4 o[4];
#pragma unroll
    for (int dt = 0; dt < 4; ++dt) o[dt] = (f32x4){0.f, 0.f, 0.f, 0.f};
#pragma unroll
    for (int g = 0; g < 5; ++g) {
        const bf16x8 P = pack8(sa[g], sb[g]);
        const LAS unsigned char* vb = lds + AT_VOFF + (16 * w + 32 * g + 8 * fq + (fr >> 2)) * AT_STRIDE + 8 * (fr & 3);
#pragma unroll
        for (int dt = 0; dt < 4; ++dt) o[dt] = mfma16(tr_pair(vb + 32 * dt, 4 * AT_STRIDE), P, o[dt]);
    }
    const float il = __builtin_amdgcn_rcpf(l);
#pragma unroll
    for (int dt = 0; dt < 4; ++dt) o[dt] = o[dt] * il;
    if (!MERGE) {
        bf16_t* dst = AO + (size_t)p * SEGE + qrow * 512 + h * 64 + 4 * fq;
#pragma unroll
        for (int dt = 0; dt < 4; ++dt) { u32x2 wv; wv.x = cvt_pk_bf16(o[dt][0], o[dt][1]); wv.y = cvt_pk_bf16(o[dt][2], o[dt][3]); *(u32x2*)(dst + 16 * dt) = wv; }
        if (fq == 0) AST[((size_t)p * 64 + b * 8 + h) * SEQ + (qrow - (size_t)b * SEQ)] = (f32x2){mx, l};
    } else {
        const float mall = fmaxf(mx, fmaxf(s0.x, s1.x));
        const float w0 = s0.y * fast_exp2(s0.x - mall), w1 = s1.y * fast_exp2(s1.x - mall), w2 = l * fast_exp2(mx - mall);
        const float iw = __builtin_amdgcn_rcpf(w0 + w1 + w2);
        float ssq = 0.f;
#pragma unroll
        for (int dt = 0; dt < 4; ++dt) {
            f32x4 v;
            v[0] = (w0 * bf_lo(x0[dt].x) + w1 * bf_lo(x1[dt].x) + w2 * o[dt][0]) * iw;
            v[1] = (w0 * bf_hi(x0[dt].x) + w1 * bf_hi(x1[dt].x) + w2 * o[dt][1]) * iw;
            v[2] = (w0 * bf_lo(x0[dt].y) + w1 * bf_lo(x1[dt].y) + w2 * o[dt][2]) * iw;
            v[3] = (w0 * bf_hi(x0[dt].y) + w1 * bf_hi(x1[dt].y) + w2 * o[dt][3]) * iw;
            o[dt] = v; ssq += (v[0] * v[0] + v[1] * v[1]) + (v[2] * v[2] + v[3] * v[3]);
        }
        ssq += __shfl_xor(ssq, 16); ssq += __shfl_xor(ssq, 32);
        const float rn = __builtin_amdgcn_rsqf(ssq * (1.0f / 64.0f) + RMS_EPS);
        bf16_t* dst = YMIX + qrow * DM + h * 64 + 4 * fq;
#pragma unroll
        for (int dt = 0; dt < 4; ++dt) {
            const f32x4 gg = *(const f32x4*)(gn_g + h * 64 + 16 * dt + 4 * fq);
            u32x2 wv; wv.x = cvt_pk_bf16(o[dt][0] * rn * gg[0], o[dt][1] * rn * gg[1]); wv.y = cvt_pk_bf16(o[dt][2] * rn * gg[2], o[dt][3] * rn * gg[3]);
            *(u32x2*)(dst + 16 * dt) = wv;
        }
    }
}

__device__ __forceinline__ void attn_decode_a(int lu, int& p, int& h, int& c, int& n) {
    const bool p1 = lu >= 256; const int v = p1 ? lu - 256 : lu, w_ = v & 63;
    p = p1 ? 1 : 0; c = p1 ? (v >> 6) : 0; h = p1 ? (w_ >> 3) : (v >> 5); n = p1 ? (w_ & 7) : (v & 31);
}
constexpr int RT_STRIDE = 272;
constexpr int RT_KOFF = 0, RT_VOFF = 128 * RT_STRIDE, RT_ROFF = 2 * 128 * RT_STRIDE;
__device__ __forceinline__ float ret_log2g(int h) { return log2f(1.0f - exp2f(-5.0f - (float)h)); }

__device__ __forceinline__ void ret_stage(LAS unsigned char* lds, const bf16_t* KR, const bf16_t* VR, size_t row0, int h, float vs_a, float vs_b) {
    const int tid = threadIdx.x;
    u32x4 kv[4], vv[4];
#pragma unroll
    for (int it = 0; it < 4; ++it) {
        const int idx = tid + 512 * it, row = idx >> 4, pc = idx & 15;
        const size_t g = (row0 + row) * 512 + h * 128 + pc * 8;
        kv[it] = *(const u32x4*)(KR + g); vv[it] = *(const u32x4*)(VR + g);
    }
#pragma unroll
    for (int it = 0; it < 4; ++it) {
        const int idx = tid + 512 * it, row = idx >> 4, pc = idx & 15;
        *(LAS u32x4*)(lds + RT_KOFF + row * RT_STRIDE + pc * 16) = kv[it];
        *(LAS u32x4*)(lds + RT_VOFF + row * RT_STRIDE + pc * 16) = scale8(vv[it], fast_exp2(vs_a + vs_b * (float)row));
    }
}

__device__ __forceinline__ void ret_state_unit(LAS unsigned char* lds, int b, int h, int c, const bf16_t* KR, const bf16_t* VR, float* KVT) {
    const int tid = threadIdx.x, lane = tid & 63, w = __builtin_amdgcn_readfirstlane(tid >> 6), fr = lane & 15, fq = lane >> 4;
    const float lg = ret_log2g(h);
    __syncthreads();
    ret_stage(lds, KR, VR, (size_t)b * SEQ + 128 * c, h, 127.0f * lg, -lg);
    __syncthreads();
    f32x4 acc[8];
#pragma unroll
    for (int dt = 0; dt < 8; ++dt) acc[dt] = (f32x4){0.f, 0.f, 0.f, 0.f};
#pragma unroll
    for (int ks = 0; ks < 4; ++ks) {
        const int mrow = 32 * ks + 8 * fq + (fr >> 2);
        const bf16x8 A = tr_pair(lds + RT_VOFF + mrow * RT_STRIDE + 32 * w + 8 * (fr & 3), 4 * RT_STRIDE);
        const LAS unsigned char* kb = lds + RT_KOFF + mrow * RT_STRIDE + 8 * (fr & 3);
#pragma unroll
        for (int dt = 0; dt < 8; ++dt) acc[dt] = mfma16(A, tr_pair(kb + 32 * dt, 4 * RT_STRIDE), acc[dt]);
    }
    float* dst = KVT + (((size_t)(b * 4 + h) * 32 + c) * 128 + 16 * w + 4 * fq) * 128 + fr;
#pragma unroll
    for (int dt = 0; dt < 8; ++dt)
#pragma unroll
        for (int j = 0; j < 4; ++j) dst[j * 128 + 16 * dt] = acc[dt][j];
}

__device__ __forceinline__ void ret_out_unit(LAS unsigned char* lds, int b, int h, int c, const bf16_t* QR, const bf16_t* KR, const bf16_t* VR, const bf16_t* GR,
                                             const bf16_t* RB, const float* gn_g, bf16_t* YMIX) {
    const int tid = threadIdx.x, lane = tid & 63, w = __builtin_amdgcn_readfirstlane(tid >> 6), fr = lane & 15, fq = lane >> 4;
    const float lg = ret_log2g(h);
    const size_t row0 = (size_t)b * SEQ + 128 * c;
    __syncthreads();
    ret_stage(lds, KR, VR, row0, h, -lg, -lg);
    {
        const bf16_t* rsrc = RB + ((size_t)(b * 4 + h) * 32 + c) * 16384;
        u32x4 rv[4];
#pragma unroll
        for (int it = 0; it < 4; ++it) { const int idx = tid + 512 * it; rv[it] = *(const u32x4*)(rsrc + (size_t)idx * 8); }
#pragma unroll
        for (int it = 0; it < 4; ++it) { const int idx = tid + 512 * it, row = idx >> 4, pc = idx & 15; *(LAS u32x4*)(lds + RT_ROFF + row * RT_STRIDE + pc * 16) = rv[it]; }
    }
    const int nq = 16 * w + fr;
    bf16x8 q[4];
#pragma unroll
    for (int ks = 0; ks < 4; ++ks) q[ks] = *(const bf16x8*)(QR + (row0 + nq) * 512 + h * 128 + 32 * ks + 8 * fq);
    __syncthreads();
    f32x4 o[8];
#pragma unroll
    for (int et = 0; et < 8; ++et) o[et] = (f32x4){0.f, 0.f, 0.f, 0.f};
    const LAS unsigned char* rb = lds + RT_ROFF + fr * RT_STRIDE + fq * 16;
#pragma unroll
    for (int et = 0; et < 8; ++et)
#pragma unroll
        for (int ks = 0; ks < 4; ++ks) o[et] = mfma16(*(const LAS bf16x8*)(rb + et * 16 * RT_STRIDE + 64 * ks), q[ks], o[et]);
    const int ng = (w >> 1) + 1;
    for (int g = 0; g < ng; ++g) {
        const int rowa = 32 * g + 8 * (fr >> 2) + (fr & 3);
        const LAS unsigned char* ka = lds + RT_KOFF + rowa * RT_STRIDE + fq * 16;
        f32x4 sa = {0.f, 0.f, 0.f, 0.f}, sb = {0.f, 0.f, 0.f, 0.f};
#pragma unroll
        for (int ks = 0; ks < 4; ++ks) {
            sa = mfma16(*(const LAS bf16x8*)(ka + 64 * ks), q[ks], sa);
            sb = mfma16(*(const LAS bf16x8*)(ka + 4 * RT_STRIDE + 64 * ks), q[ks], sb);
        }
#pragma unroll
        for (int j = 0; j < 4; ++j) { const int ma = 32 * g + 8 * fq + j; sa[j] = (ma <= nq) ? sa[j] : 0.f; sb[j] = (ma + 4 <= nq) ? sb[j] : 0.f; }
        const bf16x8 P = pack8(sa, sb);
        const LAS unsigned char* vb = lds + RT_VOFF + (32 * g + 8 * fq + (fr >> 2)) * RT_STRIDE + 8 * (fr & 3);
#pragma unroll
        for (int et = 0; et < 8; ++et) o[et] = mfma16(tr_pair(vb + 32 * et, 4 * RT_STRIDE), P, o[et]);
    }
    const float xi = fast_exp2(lg * (float)(nq + 1));
    float s = 0.f;
#pragma unroll
    for (int et = 0; et < 8; ++et) { o[et] = o[et] * xi; s += (o[et][0] + o[et][1]) + (o[et][2] + o[et][3]); }
    s += __shfl_xor(s, 16); s += __shfl_xor(s, 32);
    const float mu = s * (1.0f / 128.0f);
    float v2 = 0.f;
#pragma unroll
    for (int et = 0; et < 8; ++et) { o[et] = o[et] - mu; v2 += (o[et][0] * o[et][0] + o[et][1] * o[et][1]) + (o[et][2] * o[et][2] + o[et][3] * o[et][3]); }
    v2 += __shfl_xor(v2, 16); v2 += __shfl_xor(v2, 32);
    const float rn = __builtin_amdgcn_rsqf(v2 * (1.0f / 128.0f) + GN_EPS);
    const bf16_t* gp = GR + (row0 + nq) * 512 + h * 128 + 4 * fq;
    bf16_t* dst = YMIX + (row0 + nq) * DM + 512 + h * 128 + 4 * fq;
#pragma unroll
    for (int et = 0; et < 8; ++et) {
        const u32x2 gw = *(const u32x2*)(gp + 16 * et);
        const f32x4 gg = *(const f32x4*)(gn_g + h * 128 + 16 * et + 4 * fq);
        const float r0 = silu_f(bf_lo(gw.x)) * (o[et][0] * rn * gg[0]), r1 = silu_f(bf_hi(gw.x)) * (o[et][1] * rn * gg[1]);
        const float r2 = silu_f(bf_lo(gw.y)) * (o[et][2] * rn * gg[2]), r3 = silu_f(bf_hi(gw.y)) * (o[et][3] * rn * gg[3]);
        u32x2 wv; wv.x = cvt_pk_bf16(r0, r1); wv.y = cvt_pk_bf16(r2, r3);
        *(u32x2*)(dst + 16 * et) = wv;
    }
}

constexpr int XS_BUF = 256 * AT_STRIDE;
__device__ __forceinline__ void xs_load(u32x4 (&v)[4], const bf16_t* src  ) {
    const int tid = threadIdx.x;
#pragma unroll
    for (int it = 0; it < 4; ++it) { const int idx = tid + 512 * it, row = idx >> 3, pc = idx & 7; v[it] = *(const u32x4*)(src + (size_t)row * 2048 + pc * 8); }
}
__device__ __forceinline__ void xs_store(LAS unsigned char* buf, const u32x4 (&v)[4]) {
    const int tid = threadIdx.x;
#pragma unroll
    for (int it = 0; it < 4; ++it) { const int idx = tid + 512 * it, row = idx >> 3, pc = idx & 7; *(LAS u32x4*)(buf + row * AT_STRIDE + pc * 16) = v[it]; }
}
__device__ __forceinline__ void xattn_qload(bf16x8 (&q)[8], int b, int h, int qb, const bf16_t* QX_) {
    const int tid = threadIdx.x, lane = tid & 63, w = tid >> 6;
    const size_t qrow = (size_t)b * SEQ + 128 * qb + 16 * w + (lane & 15);
#pragma unroll
    for (int ks = 0; ks < 8; ++ks) q[ks] = *(const bf16x8*)(QX_ + qrow * DM + h * 256 + 32 * ks + 8 * (lane >> 4));
}
__device__ __forceinline__ void xattn_unit(LAS unsigned char* lds, u32x4 (&pv)[4], bf16x8 (&qn)[8], int b, int h, int qb, bool has_next, int nh, int nqb,
                                           const bf16_t* QX_, const bf16_t* MKV, bf16_t* OX_) {
    const int tid = threadIdx.x, lane = tid & 63, w = __builtin_amdgcn_readfirstlane(tid >> 6), fr = lane & 15, fq = lane >> 4;
    const size_t qrow = (size_t)b * SEQ + 128 * qb + 16 * w + fr;
    const bf16_t* kbase = MKV + (size_t)(b * NMEM) * 2048 + h * 256;
    const bf16_t* vbase = kbase + 1024;
    bf16x8 q[8];
#pragma unroll
    for (int ks = 0; ks < 8; ++ks) q[ks] = qn[ks];
    f32x4 sa[8], sb[8];
#pragma unroll
    for (int g = 0; g < 8; ++g) { sa[g] = (f32x4){0.f, 0.f, 0.f, 0.f}; sb[g] = (f32x4){0.f, 0.f, 0.f, 0.f}; }
#pragma unroll
    for (int s = 0; s < 4; ++s) {
        LAS unsigned char* buf = lds + (s & 1) * XS_BUF;
        xs_store(buf, pv);
        xs_load(pv, s < 3 ? kbase + 64 * (s + 1) : vbase);
        __syncthreads();
#pragma unroll
        for (int g = 0; g < 8; ++g) {
            const int rowa = 32 * g + 8 * (fr >> 2) + (fr & 3);
            const LAS unsigned char* ka = buf + rowa * AT_STRIDE + fq * 16;
            sa[g] = mfma16(*(const LAS bf16x8*)(ka), q[2 * s], sa[g]);
            sa[g] = mfma16(*(const LAS bf16x8*)(ka + 64), q[2 * s + 1], sa[g]);
            sb[g] = mfma16(*(const LAS bf16x8*)(ka + 4 * AT_STRIDE), q[2 * s], sb[g]);
            sb[g] = mfma16(*(const LAS bf16x8*)(ka + 4 * AT_STRIDE + 64), q[2 * s + 1], sb[g]);
        }
    }
    float mx = -1e30f;
#pragma unroll
    for (int g = 0; g < 8; ++g)
#pragma unroll
        for (int j = 0; j < 4; ++j) mx = max3_raw(mx, sa[g][j], sb[g][j]);
    mx = fmaxf(mx, __shfl_xor(mx, 16)); mx = fmaxf(mx, __shfl_xor(mx, 32));
    const f32x4 mx4 = {mx, mx, mx, mx};
    f32x4 l4 = {0.f, 0.f, 0.f, 0.f};
    bf16x8 P[8];
#pragma unroll
    for (int g = 0; g < 8; ++g) {
        sa[g] = sa[g] - mx4; sb[g] = sb[g] - mx4;
#pragma unroll
        for (int j = 0; j < 4; ++j) { sa[g][j] = fast_exp2(sa[g][j]); sb[g][j] = fast_exp2(sb[g][j]); }
        l4 = l4 + sa[g]; l4 = l4 + sb[g];
        P[g] = pack8(sa[g], sb[g]);
    }
    float l = (l4[0] + l4[1]) + (l4[2] + l4[3]);
    l += __shfl_xor(l, 16); l += __shfl_xor(l, 32);
    const float il = __builtin_amdgcn_rcpf(l);
    bf16_t* dst = OX_ + qrow * DM + h * 256 + 4 * fq;
#pragma unroll
    for (int s = 0; s < 4; ++s) {
        LAS unsigned char* buf = lds + (s & 1) * XS_BUF;
        xs_store(buf, pv);
        if (s < 3) xs_load(pv, vbase + 64 * (s + 1));
        else if (has_next) xs_load(pv, MKV + (size_t)(b * NMEM) * 2048 + nh * 256);
        if (s == 0 && has_next) xattn_qload(qn, b, nh, nqb, QX_);
        __syncthreads();
        f32x4 o[4];
#pragma unroll
        for (int dt = 0; dt < 4; ++dt) o[dt] = (f32x4){0.f, 0.f, 0.f, 0.f};
#pragma unroll
        for (int g = 0; g < 8; ++g) {
            const LAS unsigned char* vb = buf + (32 * g + 8 * fq + (fr >> 2)) * AT_STRIDE + 8 * (fr & 3);
#pragma unroll
            for (int dt = 0; dt < 4; ++dt) o[dt] = mfma16(tr_pair(vb + 32 * dt, 4 * AT_STRIDE), P[g], o[dt]);
        }
#pragma unroll
        for (int dt = 0; dt < 4; ++dt) { u32x2 wv; wv.x = cvt_pk_bf16(o[dt][0] * il, o[dt][1] * il); wv.y = cvt_pk_bf16(o[dt][2] * il, o[dt][3] * il); *(u32x2*)(dst + 64 * s + 16 * dt) = wv; }
    }
}

__device__ __forceinline__ void grid_barrier(unsigned* bar, unsigned round) {
    asm volatile("s_waitcnt vmcnt(0) lgkmcnt(0)" ::: "memory");
    __syncthreads();
    if (threadIdx.x == 0) {
        __builtin_amdgcn_fence(__ATOMIC_RELEASE, "agent");
        asm volatile("s_waitcnt vmcnt(0)" ::: "memory");
        const unsigned G = gridDim.x;
        if ((G & 7u) == 0u) {
            const unsigned g = blockIdx.x & 7u, per = G >> 3;
            unsigned* cnt = bar + 64 * (1 + g); unsigned* gen = bar + 64 * (9 + g); unsigned* top = bar + 64 * 17;
            const unsigned old = __hip_atomic_fetch_add(cnt, 1u, __ATOMIC_RELAXED, __HIP_MEMORY_SCOPE_AGENT);
            if (old + 1u == round * per) {
                __hip_atomic_fetch_add(top, 1u, __ATOMIC_RELAXED, __HIP_MEMORY_SCOPE_AGENT);
                while (__hip_atomic_load(top, __ATOMIC_RELAXED, __HIP_MEMORY_SCOPE_AGENT) < round * 8u) __builtin_amdgcn_s_sleep(1);
                __hip_atomic_store(gen, round, __ATOMIC_RELAXED, __HIP_MEMORY_SCOPE_AGENT);
            } else {
                while (__hip_atomic_load(gen, __ATOMIC_RELAXED, __HIP_MEMORY_SCOPE_AGENT) < round) __builtin_amdgcn_s_sleep(1);
            }
        } else {
            __hip_atomic_fetch_add(bar, 1u, __ATOMIC_RELAXED, __HIP_MEMORY_SCOPE_AGENT);
            while (__hip_atomic_load(bar, __ATOMIC_RELAXED, __HIP_MEMORY_SCOPE_AGENT) < round * G) __builtin_amdgcn_s_sleep(2);
        }
        __builtin_amdgcn_fence(__ATOMIC_ACQUIRE, "agent");
        asm volatile("s_waitcnt vmcnt(0)" ::: "memory");
    }
    __syncthreads();
}
__device__ __forceinline__ void grid_barrier_xcd(unsigned* bar, unsigned round, volatile LAS unsigned* ctl) {
    asm volatile("s_waitcnt vmcnt(0) lgkmcnt(0)" ::: "memory");
    __syncthreads();
    if (threadIdx.x == 0) {
        const unsigned x = ctl[0], per = ctl[1], nx = ctl[2], r1 = round - 1u;
        unsigned* cnt = bar + 64 * (26 + x); unsigned* gen = bar + 64 * (34 + x); unsigned* top = bar + 64 * 42;
        const unsigned old = __hip_atomic_fetch_add(cnt, 1u, __ATOMIC_RELAXED, __HIP_MEMORY_SCOPE_AGENT);
        if (old + 1u == r1 * per) {
            __builtin_amdgcn_fence(__ATOMIC_RELEASE, "agent");
            asm volatile("s_waitcnt vmcnt(0)" ::: "memory");
            __hip_atomic_fetch_add(top, 1u, __ATOMIC_RELAXED, __HIP_MEMORY_SCOPE_AGENT);
            while (__hip_atomic_load(top, __ATOMIC_RELAXED, __HIP_MEMORY_SCOPE_AGENT) < r1 * nx) __builtin_amdgcn_s_sleep(1);
            __hip_atomic_store(gen, round, __ATOMIC_RELAXED, __HIP_MEMORY_SCOPE_AGENT);
        } else {
            while (__hip_atomic_load(gen, __ATOMIC_RELAXED, __HIP_MEMORY_SCOPE_AGENT) < round) __builtin_amdgcn_s_sleep(1);
        }
        __builtin_amdgcn_fence(__ATOMIC_ACQUIRE, "agent");
        asm volatile("s_waitcnt vmcnt(0)" ::: "memory");
    }
    __syncthreads();
}
#define GRID_SYNC() do { ++bar_round; \
    if (bar_round == 1) { grid_barrier((unsigned*)P.ws, 1u); \
        if (threadIdx.x == 0) { unsigned nx_ = 0u; for (unsigned j_ = 0; j_ < 8u; ++j_) { const unsigned c_ = __hip_atomic_load((unsigned*)P.ws + 64 * (18 + j_), __ATOMIC_RELAXED, __HIP_MEMORY_SCOPE_AGENT); nx_ += c_ ? 1u : 0u; if (j_ == bctl[0]) bctl[1] = c_; } bctl[2] = nx_; } } \
    else grid_barrier_xcd((unsigned*)P.ws, (unsigned)bar_round, bctl); } while (0)
__global__ void __launch_bounds__(512, 2) hymba_fwd(Params P) {
    extern __shared__ __attribute__((aligned(16))) unsigned char lds_raw[];
    LAS unsigned char* lds = (LAS unsigned char*)lds_raw;
    cg::grid_group grid = cg::this_grid();
    const int tid = threadIdx.x, lane = tid & 63, wave = __builtin_amdgcn_readfirstlane(tid >> 6);
    const int G = gridDim.x, bid = blockIdx.x;
    int bar_round = 0;
    volatile LAS unsigned* bctl = (volatile LAS unsigned*)(lds + 135168);
    if (threadIdx.x == 0) {
        const unsigned xcc = (unsigned)__builtin_amdgcn_s_getreg((3 << 11) | 20) & 7u;
        bctl[0] = xcc;
        __hip_atomic_fetch_add((unsigned*)P.ws + 64 * (18 + xcc), 1u, __ATOMIC_RELAXED, __HIP_MEMORY_SCOPE_AGENT);
    }
    const int gw = bid * 8 + wave, NGW = G * 8;
    const int xcd = bid & 7, slot = bid >> 3, nslot = G >> 3;
#define WSP(TYPE, OFF) ((TYPE*)(P.ws + (OFF)))
#define XIN (P.in[0])
#define MEMIN (P.in[1])
#define WT_IN WSP(bf16_t, WS_WT_IN)
#define WT_OUT WSP(bf16_t, WS_WT_OUT)
#define WT_Q WSP(bf16_t, WS_WT_Q)
#define WT_KV WSP(bf16_t, WS_WT_KV)
#define WT_O WSP(bf16_t, WS_WT_O)
#define WT_GU WSP(bf16_t, WS_WT_GU)
#define WT_DN WSP(bf16_t, WS_WT_DN)
#define ROPEA WSP(f32x2, WS_ROPEA)
#define ROPER WSP(f32x2, WS_ROPER)
#define RSTD0 WSP(float, WS_RSTD)
#define RSTD1 (WSP(float, WS_RSTD) + T)
#define RSTD2 (WSP(float, WS_RSTD) + 2 * T)
#define RSTDM (WSP(float, WS_RSTD) + 3 * T)
#define SS1 WSP(float, WS_SSP)
#define SS2 (WSP(float, WS_SSP) + (size_t)T * 16)
#define SS3 (WSP(float, WS_SSP) + (size_t)T * 32)
#define MEMB WSP(bf16_t, WS_MEMB)
#define MEMKV WSP(bf16_t, WS_MEMKV)
#define AST WSP(f32x2, WS_AST)
#define XB WSP(bf16_t, WS_XB)
#define KVT (P.out)
#define YOUT WSP(bf16_t, WS_YOUT)
#define AO WSP(bf16_t, WS_AO)
#define YMIX WSP(bf16_t, WS_YMIX)
#define PROJ WSP(bf16_t, WS_PROJ)
#define RB WSP(bf16_t, WS_RB)
#define QA PROJ
#define KA (PROJ + SEGE)
#define VA (PROJ + 2 * SEGE)
#define QR (PROJ + 3 * SEGE)
#define KR (PROJ + 4 * SEGE)
#define VR (PROJ + 5 * SEGE)
#define GR (PROJ + 6 * SEGE)
#define QX PROJ
#define OX (PROJ + 2 * SEGE)
#define HFF PROJ

    {
        LAS float* scr = (LAS float*)(lds + wave * 16384);
        constexpr int I_IN = (DM / 64) * (NPROJ / 32), I_SQ = (DM / 64) * (DM / 32), I_KV = (DM / 64) * (2 * DM / 32), I_GU = (DM / 64) * (2 * FFH / 32), I_DN = (FFH / 64) * (DM / 32);
        constexpr int NITEMS = I_IN + 3 * I_SQ + I_KV + I_GU + I_DN;
        if (wave < 4) {
        for (int it = gw; it < NITEMS; it += NGW) {
            int r = it;
            if (r < I_IN) { transpose_item<1>(P.in[4], P.in[2], DM, NPROJ, WT_IN, scr, r, lane); continue; } r -= I_IN;
            if (r < I_SQ) { transpose_item<0>(P.in[7], nullptr, DM, DM, WT_OUT, scr, r, lane); continue; } r -= I_SQ;
            if (r < I_SQ) { transpose_item<0>(P.in[11], P.in[8], DM, DM, WT_Q, scr, r, lane); continue; } r -= I_SQ;
            if (r < I_KV) { transpose_item<0>(P.in[12], P.in[10], DM, 2 * DM, WT_KV, scr, r, lane); continue; } r -= I_KV;
            if (r < I_SQ) { transpose_item<0>(P.in[13], nullptr, DM, DM, WT_O, scr, r, lane); continue; } r -= I_SQ;
            if (r < I_GU) { transpose_item<2>(P.in[16], P.in[14], DM, 2 * FFH, WT_GU, scr, r, lane); continue; } r -= I_GU;
            transpose_item<0>(P.in[17], nullptr, FFH, DM, WT_DN, scr, r, lane);
        }
        }
        for (int pb = bid * 16; pb < SEQ; pb += G * 16)
        for (int idx = tid; idx < 16 * 72; idx += 512) {
            const int pos = pb + idx / 72, k = idx % 72;
            const float inv = k < 8 ? P.inv_att[k] : P.inv_ret[k - 8];
            const float ang = (float)pos * inv;
            const double a = (double)ang;
            const double kk = __builtin_rint(a * 0.15915494309189535);
            const float rr = (float)(a - kk * 6.283185307179586);
            const f32x2 cs = {__cosf(rr), __sinf(rr)};
            if (k < 8) ROPEA[pos * 8 + k] = cs; else ROPER[pos * 64 + (k - 8)] = cs;
        }
        for (int ch = slot; ch < SEQ / 32; ch += nslot)
            for (int row = xcd * SEQ + ch * 32 + wave; row < xcd * SEQ + ch * 32 + 32; row += 16)
                rows2_to_bf16(XIN + (size_t)row * DM, XIN + (size_t)(row + 8) * DM, XB + (size_t)row * DM, XB + (size_t)(row + 8) * DM, RSTD0 + row, RSTD0 + row + 8, lane);
        if (wave >= 4) {
        for (int it = gw; it < NITEMS; it += NGW) {
            int r = it;
            if (r < I_IN) { transpose_item<1>(P.in[4], P.in[2], DM, NPROJ, WT_IN, scr, r, lane); continue; } r -= I_IN;
            if (r < I_SQ) { transpose_item<0>(P.in[7], nullptr, DM, DM, WT_OUT, scr, r, lane); continue; } r -= I_SQ;
            if (r < I_SQ) { transpose_item<0>(P.in[11], P.in[8], DM, DM, WT_Q, scr, r, lane); continue; } r -= I_SQ;
            if (r < I_KV) { transpose_item<0>(P.in[12], P.in[10], DM, 2 * DM, WT_KV, scr, r, lane); continue; } r -= I_KV;
            if (r < I_SQ) { transpose_item<0>(P.in[13], nullptr, DM, DM, WT_O, scr, r, lane); continue; } r -= I_SQ;
            if (r < I_GU) { transpose_item<2>(P.in[16], P.in[14], DM, 2 * FFH, WT_GU, scr, r, lane); continue; } r -= I_GU;
            transpose_item<0>(P.in[17], nullptr, FFH, DM, WT_DN, scr, r, lane);
        }
        }
        for (int ch = slot; ch < NMEM / 32; ch += nslot)
            for (int row = xcd * NMEM + ch * 32 + wave; row < xcd * NMEM + ch * 32 + 32; row += 8) row_to_bf16(MEMIN + (size_t)row * DM, MEMB + (size_t)row * DM, RSTDM + row, lane);
    }
    GRID_SYNC();
    grid.sync();
    {
        pg8::Gemm g{XB, WT_IN, T, NPROJ, DM}; pg8::StaticOrder S; S.init(T, NPROJ, G, bid);
        pg8::EpiProj E{PROJ, RSTD0, ROPEA, ROPER};
        pg8::gemm_phase<pg8::EpiProj, pg8::StaticOrder, true, true>(lds, g, S, E);
    }
    GRID_SYNC();
    {
        u32x4 kv[4], vv[4]; bf16x8 qq[2];
        int p_, h_, c_, n_;
        attn_decode_a(slot, p_, h_, c_, n_);
        if (slot < 512) attn_load(kv, vv, qq, p_, xcd, h_, c_, n_, QA, KA, VA);
        for (int lu = slot; lu < 512; lu += nslot) {
            int np = 0, nh = 0, nc = 0, nn = 0; const bool has_next = lu + nslot < 512;
            if (has_next) attn_decode_a(lu + nslot, np, nh, nc, nn);
            attn_unit<false>(lds, kv, vv, qq, p_, xcd, h_, c_, n_, has_next, np, nh, nc, nn, QA, KA, VA, AO, AST, nullptr, nullptr);
            p_ = np; h_ = nh; c_ = nc; n_ = nn;
        }
    }
    for (int lu = 512 + slot; lu < 640; lu += nslot) { const int v = lu - 512; ret_state_unit(lds, xcd, v >> 5, v & 31, KR, VR, KVT); }
    GRID_SYNC();
    {
        for (int it = slot * 512 + tid; it < 4 * 4096; it += nslot * 512) {
            const int bh = xcd * 4 + (it >> 12), off = (it & 4095) * 4;
            const float dec = fast_exp2(128.0f * ret_log2g(bh & 3));
            f32x4 R = {0.f, 0.f, 0.f, 0.f};
            for (int c0 = 0; c0 < 32; c0 += 8) {
                f32x4 kv[8];
#pragma unroll
                for (int c = 0; c < 8; ++c) kv[c] = *(const f32x4*)(KVT + ((size_t)bh * 32 + c0 + c) * 16384 + off);
#pragma unroll
                for (int c = 0; c < 8; ++c) {
                    u32x2 wv; wv.x = cvt_pk_bf16(R[0], R[1]); wv.y = cvt_pk_bf16(R[2], R[3]);
                    *(u32x2*)(RB + ((size_t)bh * 32 + c0 + c) * 16384 + off) = wv;
                    R = R * dec + kv[c];
                }
            }
        }
    }
    {
        pg8::Gemm g{MEMB, WT_KV, MROWS, 2 * DM, DM}; pg8::StaticOrder S; S.init(MROWS, 2 * DM, G, bid);
        pg8::EpiScale E{MEMKV, 2 * DM, RSTDM, 1.0f};
        pg8::gemm_phase<pg8::EpiScale, pg8::StaticOrder, true, true>(lds, g, S, E);
    }
    {
        const bool uneven = (nslot == 32);
        const int first = !uneven ? slot : (slot >= 8 ? slot - 8 : 216 + slot), stride = !uneven ? nslot : (slot >= 8 ? 24 : 8);
        const int last = !uneven ? 256 : (slot >= 8 ? 216 : 256);
        u32x4 kv[4], vv[4]; bf16x8 qq[2];
        if (first < last) attn_load(kv, vv, qq, 2, xcd, first >> 5, (first & 31) >> 1, first & 1, QA, KA, VA);
        for (int lu = first; lu < last; lu += stride) {
            const int ln = lu + stride; const bool has_next = ln < last;
            attn_unit<true>(lds, kv, vv, qq, 2, xcd, lu >> 5, (lu & 31) >> 1, lu & 1, has_next, 2, ln >> 5, (ln & 31) >> 1, ln & 1, QA, KA, VA, AO, AST, P.in[5], YMIX);
        }
    }
    GRID_SYNC();
    for (int lu = slot; lu < 128; lu += nslot) ret_out_unit(lds, xcd, lu >> 5, lu & 31, QR, KR, VR, GR, RB, P.in[6], YMIX);
    __syncthreads();
    GRID_SYNC();
    {
        pg8::Gemm g{YMIX, WT_OUT, T, DM, DM}; pg8::StaticOrder S; S.init(T, DM, G, bid);
        pg8::EpiYss E{YOUT, SS1};
        pg8::gemm_phase<pg8::EpiYss, pg8::StaticOrder, true, true>(lds, g, S, E);
    }
    GRID_SYNC();
    residual_pass<false>(XB, YOUT, SS1, P.in[3], nullptr, RSTD1);
    GRID_SYNC();
    {
        pg8::Gemm g{XB, WT_Q, T, DM, DM}; pg8::StaticOrder S; S.init(T, DM, G, bid);
        pg8::EpiScale E{QX, DM, RSTD1, 0.0625f * LOG2E};
        pg8::gemm_phase<pg8::EpiScale, pg8::StaticOrder, true, true>(lds, g, S, E);
        asm volatile("s_waitcnt vmcnt(0)" ::: "memory");
        __syncthreads();
        pg8::Unit u, un;
        u32x4 pv[4]; bf16x8 qn[8];
        bool have = S.next(0, u);
        if (have) { xs_load(pv, MEMKV + (size_t)((u.pm >> 4) * NMEM) * 2048 + u.pn * 256); xattn_qload(qn, u.pm >> 4, u.pn, (u.pm & 15) * 2, QX); }
        for (int i = 0; have; ++i) {
            const bool more = S.next(i + 1, un);
            const int b_ = u.pm >> 4, h_ = u.pn, qb_ = (u.pm & 15) * 2;
            xattn_unit(lds, pv, qn, b_, h_, qb_, true, h_, qb_ + 1, QX, MEMKV, OX);
            xattn_unit(lds, pv, qn, b_, h_, qb_ + 1, more, un.pn, (un.pm & 15) * 2, QX, MEMKV, OX);
            u = un; have = more;
        }
    }
    __syncthreads();
    GRID_SYNC();
    {
        pg8::Gemm g{OX, WT_O, T, DM, DM}; pg8::StaticOrder S; S.init(T, DM, G, bid);
        pg8::EpiYss E{YOUT, SS2};
        pg8::gemm_phase<pg8::EpiYss, pg8::StaticOrder, true, true>(lds, g, S, E);
    }
    GRID_SYNC();
    residual_pass<false>(XB, YOUT, SS2, P.in[9], nullptr, RSTD2);
    GRID_SYNC();
    {
        pg8::Gemm g{XB, WT_GU, T, 2 * FFH, DM}; pg8::StaticOrder S; S.init(T, 2 * FFH, G, bid);
        pg8::EpiSwiGLU E{HFF, RSTD2};
        pg8::gemm_phase<pg8::EpiSwiGLU, pg8::StaticOrder, true, true>(lds, g, S, E);
    }
    GRID_SYNC();
    {
        pg8::Gemm g{HFF, WT_DN, T, DM, FFH}; pg8::StaticOrder S; S.init(T, DM, G, bid);
        pg8::EpiYss E{YOUT, SS3};
        pg8::gemm_phase<pg8::EpiYss, pg8::StaticOrder, true, true>(lds, g, S, E);
    }
    GRID_SYNC();
    residual_pass<true>(XB, YOUT, SS3, P.in[15], P.out, nullptr);
}

extern "C" void kernel_launch(void* const* d_in, const int* in_sizes, int n_in, void* d_out, int out_size, void* d_ws, size_t ws_size, hipStream_t stream) {
    static int grid = 0;
    if (grid == 0) {
        if (n_in != 18 || ws_size < WS_END) { fprintf(stderr, "kernel_launch: unexpected problem (n_in %d, ws %zu)\n", n_in, ws_size); grid = -1; return; }
        int dev = 0, cus = 0, per_cu = 0;
        hipGetDevice(&dev);
        hipDeviceGetAttribute(&cus, hipDeviceAttributeMultiprocessorCount, dev);
        if (hipFuncSetAttribute((const void*)hymba_fwd, hipFuncAttributeMaxDynamicSharedMemorySize, LDS_BYTES) != hipSuccess) { fprintf(stderr, "kernel_launch: hipFuncSetAttribute failed\n"); grid = -1; return; }
        if (hipOccupancyMaxActiveBlocksPerMultiprocessor(&per_cu, (const void*)hymba_fwd, 512, LDS_BYTES) != hipSuccess || per_cu < 1) { fprintf(stderr, "kernel_launch: occupancy query failed (%d)\n", per_cu); (void)hipGetLastError(); grid = -1; return; }
        grid = cus * 1;
        if (grid < 8 || (grid & 7) != 0) { fprintf(stderr, "kernel_launch: the batch-affine work mapping needs a grid that is a multiple of 8 (got %d); nothing launched\n", grid); grid = -1; return; }
    }
    if (grid < 0) return;
    Params p{};
    for (int i = 0; i < 18; ++i) p.in[i] = (const float*)d_in[i];
    p.out = (float*)d_out; p.ws = (unsigned char*)d_ws;
    for (int i = 0; i < 8; ++i) p.inv_att[i] = powf(500000.0f, -((float)(2 * i) / 16.0f));
    for (int i = 0; i < 64; ++i) p.inv_ret[i] = powf(10000.0f, -((float)(2 * i) / 128.0f));
    if (hipMemsetAsync(d_ws, 0, 16384, stream) != hipSuccess) { fprintf(stderr, "kernel_launch: memset of the barrier word failed\n"); return; }
    void* args[] = {&p};
    hipError_t e = hipLaunchCooperativeKernel((const void*)hymba_fwd, dim3(grid), dim3(512), args, LDS_BYTES, stream);
    if (e != hipSuccess) fprintf(stderr, "kernel_launch: cooperative launch failed: %s (grid %d)\n", hipGetErrorString(e), grid);
}
```
